# Optimizing an MI355X kernel written in HIP

```python
import jax, jax.numpy as jnp
from jax import lax
import numpy as np

D_MODEL = 1024
BATCH = 2
SEQ = 8192
DEPTH = 1

GRID_W = 64
ML_HEADS = 4
ML_DH = 128
ML_WIDTH = ML_HEADS * ML_DH
ML_CHUNK = 64
CONV_W = 5
NA_HEADS = 8
NA_DH = 64
NA_WIDTH = NA_HEADS * NA_DH
NA_KH_MAX = 8
NA_KW = 16
D_MIX = ML_WIDTH + NA_WIDTH
N_GATES = 4 * ML_HEADS
D_IN = 3 * ML_WIDTH + N_GATES + 3 * NA_WIDTH
SPLITS = (ML_WIDTH, 2 * ML_WIDTH, 3 * ML_WIDTH, 3 * ML_WIDTH + N_GATES,
          3 * ML_WIDTH + N_GATES + NA_WIDTH, 3 * ML_WIDTH + N_GATES + 2 * NA_WIDTH)
D_FF = 2816
EPS = 1e-6

kernel_name = "hybrid_mlstm_natten_macaron_encoder"


def rmsnorm(x, g):
    xf = x.astype(jnp.float32)
    y = xf * lax.rsqrt(jnp.mean(xf * xf, axis=-1, keepdims=True) + EPS)
    return (y * g.astype(jnp.float32)).astype(x.dtype)


def swiglu(x, w_gate, w_up, w_down):
    return (jax.nn.silu(x @ w_gate) * (x @ w_up)) @ w_down


def dwconv_centred(u, w, b):
    C = u.shape[-1]
    y = lax.conv_general_dilated(
        u, w[:, None, :].astype(u.dtype), window_strides=(1,),
        padding=[(CONV_W // 2, CONV_W // 2)],
        dimension_numbers=("NWC", "WIO", "NWC"), feature_group_count=C)
    return y + b


def mlstm_chunkwise(q, k, v, log_i, log_f):
    B, H, T, d = q.shape
    L = ML_CHUNK
    NC = T // L
    q = q.astype(jnp.float32).reshape(B, H, NC, L, d)
    k = k.astype(jnp.float32).reshape(B, H, NC, L, d)
    v = v.astype(jnp.float32).reshape(B, H, NC, L, d)
    li = log_i.reshape(B, H, NC, L)
    lf = log_f.reshape(B, H, NC, L)
    b = jnp.cumsum(lf, axis=-1)
    g = b[..., -1]
    a = g[..., None] - b + li
    m_loc = jnp.max(a, axis=-1)
    w = jnp.exp(a - m_loc[..., None])
    C_loc = jnp.einsum('bhnl,bhnld,bhnle->bhnde', w, v, k)
    n_loc = jnp.einsum('bhnl,bhnle->bhne', w, k)

    def step(carry, xs):
        C, n, m = carry
        g_k, ml_k, Cl_k, nl_k = xs
        m_new = jnp.maximum(g_k + m, ml_k)
        s_old = jnp.exp(g_k + m - m_new)
        s_loc = jnp.exp(ml_k - m_new)
        C_new = s_old[..., None, None] * C + s_loc[..., None, None] * Cl_k
        n_new = s_old[..., None] * n + s_loc[..., None] * nl_k
        return (C_new, n_new, m_new), (C, n, m)

    init = (jnp.zeros((B, H, d, d), jnp.float32), jnp.zeros((B, H, d), jnp.float32),
            jnp.zeros((B, H), jnp.float32))
    xs = (jnp.moveaxis(g, 2, 0), jnp.moveaxis(m_loc, 2, 0),
          jnp.moveaxis(C_loc, 2, 0), jnp.moveaxis(n_loc, 2, 0))
    _, (C0, n0, m0) = lax.scan(step, init, xs)
    C0 = jnp.moveaxis(C0, 0, 2)
    n0 = jnp.moveaxis(n0, 0, 2)
    m0 = jnp.moveaxis(m0, 0, 2)

    D = b[..., :, None] - b[..., None, :] + li[..., None, :]
    mask = np.tril(np.ones((L, L), dtype=bool))
    D = jnp.where(mask, D, -jnp.inf)
    inter = b + m0[..., None]
    m_t = jnp.maximum(inter, jnp.max(D, axis=-1))
    s = jnp.einsum('bhnld,bhnsd->bhnls', q, k) * jnp.exp(D - m_t[..., None])
    sc_inter = jnp.exp(inter - m_t)
    num = jnp.einsum('bhnls,bhnsd->bhnld', s, v) + \
        sc_inter[..., None] * jnp.einsum('bhnde,bhnle->bhnld', C0, q)
    den = jnp.sum(s, axis=-1) + sc_inter * jnp.einsum('bhne,bhnle->bhnl', n0, q)
    den = jnp.maximum(jnp.abs(den), jnp.exp(-m_t))
    h = num / den[..., None]
    return h.reshape(B, H, T, d)


def mlstm_mixer(c, v, o, gates, conv_w, conv_b, w_q, w_k, gn):
    B, T, _ = c.shape
    u = jax.nn.silu(dwconv_centred(c, conv_w, conv_b)).reshape(B, T, ML_HEADS, ML_DH)
    q = jnp.einsum('bthd,hde->bhte', u, w_q)
    k = jnp.einsum('bthd,hde->bhte', u, w_k) * (ML_DH ** -0.5)
    vh = v.reshape(B, T, ML_HEADS, ML_DH).transpose(0, 2, 1, 3)
    gt = gates.astype(jnp.float32).reshape(B, T, 2, 2, ML_HEADS).transpose(2, 3, 0, 4, 1)
    log_i = gt[:, 0]
    log_f = jax.nn.log_sigmoid(gt[:, 1])
    flip = lambda a: jnp.flip(a, axis=2)
    h_fwd = mlstm_chunkwise(q, k, vh, log_i[0], log_f[0])
    h_bwd = flip(mlstm_chunkwise(flip(q), flip(k), flip(vh), flip(log_i[1]), flip(log_f[1])))
    hs = (h_fwd + h_bwd).transpose(0, 2, 1, 3)
    hn = rmsnorm(hs, gn).reshape(B, T, ML_WIDTH)
    return (jax.nn.sigmoid(o.astype(jnp.float32)) * hn).astype(c.dtype)


def na_mixer(q, k, v, gq, gk, rpb):
    B, T, _ = q.shape
    rows = T // GRID_W
    kh = min(NA_KH_MAX, rows)
    qh = rmsnorm(q.reshape(B, T, NA_HEADS, NA_DH), gq) * (NA_DH ** -0.5)
    khd = rmsnorm(k.reshape(B, T, NA_HEADS, NA_DH), gk)
    to_grid = lambda a: a.reshape(B, rows, GRID_W, NA_HEADS, NA_DH).transpose(0, 3, 1, 2, 4)
    qg, kg = to_grid(qh), to_grid(khd)
    vg = to_grid(v.reshape(B, T, NA_HEADS, NA_DH))
    col_start = np.clip(np.arange(GRID_W) - NA_KW // 2, 0, GRID_W - NA_KW)
    col_idx = col_start[:, None] + np.arange(NA_KW)[None, :]
    dc_idx = col_idx - np.arange(GRID_W)[:, None] + (NA_KW - 1)

    def row_block(r):
        rs = jnp.clip(r - kh // 2, 0, rows - kh)
        k_rows = lax.dynamic_slice_in_dim(kg, rs, kh, axis=2)
        v_rows = lax.dynamic_slice_in_dim(vg, rs, kh, axis=2)
        k_win = k_rows[:, :, :, col_idx, :]
        v_win = v_rows[:, :, :, col_idx, :]
        q_r = lax.dynamic_index_in_dim(qg, r, axis=2, keepdims=False)
        s = jnp.einsum('bhcd,bhrcwd->bhcrw', q_r, k_win).astype(jnp.float32)
        dr = rs + jnp.arange(kh) - r + (NA_KH_MAX - 1)
        bias = rpb[:, dr][:, :, dc_idx].transpose(0, 2, 1, 3)
        s = s + bias[None].astype(jnp.float32)
        p = jax.nn.softmax(s.reshape(B, NA_HEADS, GRID_W, kh * NA_KW), axis=-1)
        p = p.reshape(B, NA_HEADS, GRID_W, kh, NA_KW).astype(v_win.dtype)
        return jnp.einsum('bhcrw,bhrcwd->bhcd', p, v_win)

    out = lax.map(row_block, jnp.arange(rows))
    return out.transpose(1, 0, 3, 2, 4).reshape(B, T, NA_WIDTH).astype(q.dtype)


def setup_inputs(seed: int = 0) -> dict:
    key = jax.random.key(seed)
    ks = jax.random.split(key, 24)
    nrm = lambda k, shape, s: jax.random.normal(k, shape, jnp.float32) * s
    gain = lambda k, shape: 1.0 + 0.02 * jax.random.normal(k, shape, jnp.float32)
    ig = 0.1 * jax.random.normal(ks[7], (DEPTH, 2, 1, ML_HEADS), jnp.float32)
    fg = jnp.linspace(3.0, 6.0, ML_HEADS, dtype=jnp.float32) + \
        0.1 * jax.random.normal(ks[8], (DEPTH, 2, 1, ML_HEADS), jnp.float32)
    b_gates = jnp.concatenate([ig, fg], axis=2).reshape(DEPTH, N_GATES)
    return {
        "x": nrm(ks[0], (BATCH, SEQ, D_MODEL), 1.0),
        "norm_ffn1": gain(ks[1], (DEPTH, D_MODEL)),
        "w1_gate": nrm(ks[2], (DEPTH, D_MODEL, D_FF), D_MODEL ** -0.5),
        "w1_up": nrm(ks[3], (DEPTH, D_MODEL, D_FF), D_MODEL ** -0.5),
        "w1_down": nrm(ks[4], (DEPTH, D_FF, D_MODEL), D_FF ** -0.5),
        "norm_mix": gain(ks[5], (DEPTH, D_MODEL)),
        "w_in": nrm(ks[6], (DEPTH, D_MODEL, D_IN), D_MODEL ** -0.5),
        "b_gates": b_gates,
        "conv_w": nrm(ks[9], (DEPTH, CONV_W, ML_WIDTH), CONV_W ** -0.5),
        "conv_b": nrm(ks[10], (DEPTH, ML_WIDTH), 0.02),
        "w_q_ml": nrm(ks[11], (DEPTH, ML_HEADS, ML_DH, ML_DH), ML_DH ** -0.5),
        "w_k_ml": nrm(ks[12], (DEPTH, ML_HEADS, ML_DH, ML_DH), ML_DH ** -0.5),
        "gn_ml": gain(ks[13], (DEPTH, ML_HEADS, ML_DH)),
        "gq_na": gain(ks[14], (DEPTH, NA_DH)),
        "gk_na": gain(ks[15], (DEPTH, NA_DH)),
        "rpb": nrm(ks[16], (DEPTH, NA_HEADS, 2 * NA_KH_MAX - 1, 2 * NA_KW - 1), 0.1),
        "w_out": nrm(ks[17], (DEPTH, D_MIX, D_MODEL), D_MIX ** -0.5),
        "norm_ffn2": gain(ks[18], (DEPTH, D_MODEL)),
        "w2_gate": nrm(ks[19], (DEPTH, D_MODEL, D_FF), D_MODEL ** -0.5),
        "w2_up": nrm(ks[20], (DEPTH, D_MODEL, D_FF), D_MODEL ** -0.5),
        "w2_down": nrm(ks[21], (DEPTH, D_FF, D_MODEL), D_FF ** -0.5),
        "norm_final": gain(ks[22], (DEPTH, D_MODEL)),
    }


def reference(x, norm_ffn1, w1_gate, w1_up, w1_down, norm_mix, w_in, b_gates, conv_w,
              conv_b, w_q_ml, w_k_ml, gn_ml, gq_na, gk_na, rpb, w_out, norm_ffn2,
              w2_gate, w2_up, w2_down, norm_final):
    for l in range(DEPTH):
        x = x + 0.5 * swiglu(rmsnorm(x, norm_ffn1[l]), w1_gate[l], w1_up[l], w1_down[l])
        h = rmsnorm(x, norm_mix[l])
        proj = h @ w_in[l]
        c_ml, v_ml, o_ml, g_ml, q_na, k_na, v_na = jnp.split(proj, SPLITS, axis=-1)
        y_ml = mlstm_mixer(c_ml, v_ml, o_ml, g_ml + b_gates[l], conv_w[l], conv_b[l],
                           w_q_ml[l], w_k_ml[l], gn_ml[l])
        y_na = na_mixer(q_na, k_na, v_na, gq_na[l], gk_na[l], rpb[l])
        x = x + jnp.concatenate([y_ml, y_na], axis=-1) @ w_out[l]
        x = x + 0.5 * swiglu(rmsnorm(x, norm_ffn2[l]), w2_gate[l], w2_up[l], w2_down[l])
        x = rmsnorm(x, norm_final[l])
    return x
```

```cpp
#include <hip/hip_runtime.h>
#include <cstdio>
#include <cstdint>
namespace pg8 {
#define PG8_LAS __attribute__((address_space(3)))
typedef unsigned short bf16_t;
typedef short bf16x8 __attribute__((ext_vector_type(8)));
typedef float f32x4 __attribute__((ext_vector_type(4)));
typedef unsigned u32x4 __attribute__((ext_vector_type(4)));
constexpr int BM = 256, BK = 64, HALF = 128, HTB = HALF * BK * 2  , STAGE_BYTES = 8 * HTB, NXCD = 8, WGM = 8;

__host__ __device__ __forceinline__ int lds_byte(int r, int c) { const int st = (r >> 4) * 2 + (c >> 5), rr = r & 15, cc = c & 31, ob = rr * 64 + cc * 2; return st * 1024 + (ob ^ (((ob >> 9) & 1) << 5)); }
__host__ __device__ __forceinline__ void stage_rc(int b, int& R, int& C) { const int st = b / 1024, sb = b % 1024, swz = sb ^ (((sb >> 9) & 1) << 5); R = (st >> 1) * 16 + swz / 64; C = (st & 1) * 32 + (swz % 64) / 2; }
__host__ __device__ __forceinline__ int perm32(int rho) { const int n = rho >> 4, i = rho & 15; return 8 * (i >> 2) + 4 * n + (i & 3); }

struct Unit { int pm, pn; };
struct Gemm { const bf16_t* A; const bf16_t* Bt; int M, N, K; };

struct StaticOrder {
    int nM, nN, nwg, G, c;
    __host__ __device__ void init(int M, int N, int G_, int c_) { nM = M / BM; nN = N / BM; nwg = nM * nN; G = G_; c = c_; }
    __host__ __device__ bool next(int i, Unit& u) const {
        const long L = (long)i * G + c; if (L >= nwg) return false;
        int wgid = (int)L; { const int q = nwg / NXCD, r = nwg % NXCD, xcd = wgid % NXCD, off = wgid / NXCD; wgid = (xcd < r ? xcd * (q + 1) : r * (q + 1) + (xcd - r) * q) + off; }
        const int nig = WGM * nN, gid = wgid / nig, fm = gid * WGM, gsz = (nM - fm) < WGM ? (nM - fm) : WGM;
        u.pm = fm + ((wgid % nig) % gsz); u.pn = (wgid % nig) / gsz; return true;
    }
    __device__ __forceinline__ void a_ready(const Unit&) const {}
    __device__ __forceinline__ void done(const Unit&) const {}
};

__device__ __forceinline__ unsigned cvt_pk_bf16(float lo, float hi) { unsigned r; asm volatile("v_cvt_pk_bf16_f32 %0, %1, %2" : "=v"(r) : "v"(lo), "v"(hi)); return r; }
typedef float f32x2 __attribute__((ext_vector_type(2)));
constexpr float RMS_EPS = 1e-6f;
__device__ __forceinline__ float rstd_from_ss(const float* ss, int row) {
    const f32x4* p = (const f32x4*)(ss + (size_t)row * 16);
    const f32x4 a = p[0], b = p[1], c = p[2], d = p[3];
    const float s = ((a[0] + a[1]) + (a[2] + a[3])) + ((b[0] + b[1]) + (b[2] + b[3])) + ((c[0] + c[1]) + (c[2] + c[3])) + ((d[0] + d[1]) + (d[2] + d[3]));
    return __builtin_amdgcn_rsqf(s * (1.0f / 1024.0f) + RMS_EPS);
}
__device__ __forceinline__ float silu_mul(float g, float u) {
    const float e = __builtin_amdgcn_exp2f(g * -1.4426950408889634f);
    return g * __builtin_amdgcn_rcpf(1.0f + e) * u;
}
struct EpiSwiGLU {
    static constexpr bool PERM = true, AFTER_DRAIN = false;
    bf16_t* H; int ldh; const float* ss;
    __device__ __forceinline__ void operator()(const f32x4 (&acc)[2][2][4][2], const Unit& u, int wr, int wc, int fr, int fq) const {
        const int row0 = u.pm * BM + wr * 64 + fr, col0 = u.pn * HALF + wc * 32 + 8 * fq;
#pragma unroll
        for (int ai = 0; ai < 2; ++ai)
#pragma unroll
            for (int m = 0; m < 4; ++m) { const int row = row0 + ai * HALF + m * 16; const float rs = rstd_from_ss(ss, row);
                const f32x4 g0 = acc[ai][0][m][0] * rs, g1 = acc[ai][0][m][1] * rs, u0 = acc[ai][1][m][0] * rs, u1 = acc[ai][1][m][1] * rs;
                u32x4 w; w.x = cvt_pk_bf16(silu_mul(g0[0], u0[0]), silu_mul(g0[1], u0[1])); w.y = cvt_pk_bf16(silu_mul(g0[2], u0[2]), silu_mul(g0[3], u0[3]));
                w.z = cvt_pk_bf16(silu_mul(g1[0], u1[0]), silu_mul(g1[1], u1[1])); w.w = cvt_pk_bf16(silu_mul(g1[2], u1[2]), silu_mul(g1[3], u1[3]));
                *(u32x4*)(H + (size_t)row * ldh + col0) = w; }
    }
};
struct EpiResid {
    static constexpr bool PERM = false, AFTER_DRAIN = false;
    const float* base; float* out; bf16_t* xb; float* ss; float alpha; int ldc;
    __device__ __forceinline__ void operator()(const f32x4 (&acc)[2][2][4][2], const Unit& u, int wr, int wc, int fr, int fq) const {
        typedef unsigned u32x2v __attribute__((ext_vector_type(2)));
        const int row0 = u.pm * BM + wr * 64 + fr, col0 = u.pn * BM + wc * 32 + 4 * fq;
#pragma unroll
        for (int ai = 0; ai < 2; ++ai)
#pragma unroll
            for (int m = 0; m < 4; ++m) { const int row = row0 + ai * HALF + m * 16; const size_t off = (size_t)row * ldc + col0; float q = 0.f;
#pragma unroll
                for (int bj = 0; bj < 2; ++bj)
#pragma unroll
                    for (int n = 0; n < 2; ++n) { const f32x4 b = *(const f32x4*)(base + off + bj * HALF + n * 16); const f32x4 o = b + acc[ai][bj][m][n] * alpha;
                        *(f32x4*)(out + off + bj * HALF + n * 16) = o; q += (o[0] * o[0] + o[1] * o[1]) + (o[2] * o[2] + o[3] * o[3]);
                        if (xb) { u32x2v w; w.x = cvt_pk_bf16(o[0], o[1]); w.y = cvt_pk_bf16(o[2], o[3]); *(u32x2v*)(xb + off + bj * HALF + n * 16) = w; } }
                q += __shfl_xor(q, 16); q += __shfl_xor(q, 32);
                if (fq == 0) ss[(size_t)row * 16 + u.pn * 4 + wc] = q; }
    }
};
struct EpiProj {
    static constexpr bool PERM = true, AFTER_DRAIN = false;
    bf16_t* P; int ldp; const float* ss;
    __device__ __forceinline__ void operator()(const f32x4 (&acc)[2][2][4][2], const Unit& u, int wr, int wc, int fr, int fq) const {
        const int row0 = u.pm * BM + wr * 64 + fr, col0 = u.pn * BM + wc * 32 + 8 * fq;
#pragma unroll
        for (int ai = 0; ai < 2; ++ai)
#pragma unroll
            for (int m = 0; m < 4; ++m) { const int row = row0 + ai * HALF + m * 16; const float rs = rstd_from_ss(ss, row);
#pragma unroll
                for (int bj = 0; bj < 2; ++bj) { const f32x4 v0 = acc[ai][bj][m][0] * rs, v1 = acc[ai][bj][m][1] * rs;
                    u32x4 w; w.x = cvt_pk_bf16(v0[0], v0[1]); w.y = cvt_pk_bf16(v0[2], v0[3]); w.z = cvt_pk_bf16(v1[0], v1[1]); w.w = cvt_pk_bf16(v1[2], v1[3]);
                    *(u32x4*)(P + (size_t)row * ldp + col0 + bj * HALF) = w; } }
    }
};
template <class Epi, class Sched, bool ALIGN_EPI = false, bool SP2 = false>
__device__ __forceinline__ void gemm_phase(PG8_LAS unsigned char* lds, const Gemm g, const Sched& S, const Epi& E) {
    const int tid = threadIdx.x, wid = __builtin_amdgcn_readfirstlane(tid >> 6), lane = tid & 63, wr = wid >> 2, wc = wid & 3, fr = lane & 15, fq = lane >> 4;
    const int K = g.K, nt = K / BK;
    unsigned voffA[2], voffB[2];
#pragma unroll
    for (int i = 0; i < 2; ++i) { int R, C; stage_rc(tid * 16 + i * 8192, R, C); const int Rb = Epi::PERM ? ((R & ~31) + perm32(R & 31)) : R;
        voffA[i] = (unsigned)(R * K + C) * 2u; voffB[i] = (unsigned)(Rb * K + C) * 2u; }
    const size_t kstep = (size_t)(BK * 2);
    const size_t hstep = (size_t)HALF * K * 2;
    const size_t tstep = 2 * hstep;
    const unsigned ldsw = (unsigned)wid * 1024u;
    const int aoff = lds_byte(wr * 64 + fr, fq * 8), boff = lds_byte(wc * 32 + fr, fq * 8);
#define PG8_SA(b, h) (((b) * 2 + (h)) * HTB)
#define PG8_SB(b, h) ((4 + (b) * 2 + (h)) * HTB)
#define PG8_STAGE(bufoff, gbase, voff) do { _Pragma("unroll") for (int _i = 0; _i < 2; ++_i) \
        __builtin_amdgcn_global_load_lds((const unsigned*)((const char*)(gbase) + (voff)[_i]), (PG8_LAS unsigned*)(lds + (bufoff) + ldsw + _i * 8192), 16, 0, 0); } while (0)
#define PG8_LDA(dst, b, h) do { _Pragma("unroll") for (int m = 0; m < 4; ++m) _Pragma("unroll") for (int k = 0; k < 2; ++k) dst[m][k] = *(const PG8_LAS bf16x8*)(lds + PG8_SA(b, h) + aoff + m * 2048 + k * 1024); } while (0)
#define PG8_LDB(dst, b, h) do { _Pragma("unroll") for (int n = 0; n < 2; ++n) _Pragma("unroll") for (int k = 0; k < 2; ++k) dst[n][k] = *(const PG8_LAS bf16x8*)(lds + PG8_SB(b, h) + boff + n * 2048 + k * 1024); } while (0)
#define PG8_MMA(ai, bj, At, Bt) do { __builtin_amdgcn_s_setprio(1); _Pragma("unroll") for (int m = 0; m < 4; ++m) _Pragma("unroll") for (int n = 0; n < 2; ++n) _Pragma("unroll") for (int k = 0; k < 2; ++k) \
        acc[ai][bj][m][n] = __builtin_amdgcn_mfma_f32_16x16x32_bf16(Bt[n][k], At[m][k], acc[ai][bj][m][n], 0, 0, 0); __builtin_amdgcn_s_setprio(0); } while (0)
#define PG8_WAIT_V(n) asm volatile("s_waitcnt vmcnt(" #n ")" ::: "memory")
#define PG8_WAIT_L(n) asm volatile("s_waitcnt lgkmcnt(" #n ")" ::: "memory")
#define PG8_BAR __builtin_amdgcn_s_barrier()
#define PG8_SCHED __builtin_amdgcn_sched_barrier(0)
    Unit cur, nxt; int ui = 0;
    if (!S.next(0, cur)) return;
    f32x4 acc[2][2][4][2];
#pragma unroll
    for (int a = 0; a < 2; ++a)
#pragma unroll
        for (int b = 0; b < 2; ++b)
#pragma unroll
            for (int m = 0; m < 4; ++m)
#pragma unroll
                for (int n = 0; n < 2; ++n) acc[a][b][m][n] = (f32x4){0.f, 0.f, 0.f, 0.f};
    bf16x8 At[4][2], B0[2][2], B1[2][2];
    const char* cA = (const char*)g.A + (size_t)cur.pm * tstep; const char* cB = (const char*)g.Bt + (size_t)cur.pn * tstep;
    S.a_ready(cur);
    if constexpr (SP2) {
        PG8_STAGE(PG8_SB(0, 0), cB, voffB); PG8_STAGE(PG8_SB(0, 1), cB + hstep, voffB); PG8_STAGE(PG8_SA(0, 0), cA, voffA); PG8_STAGE(PG8_SA(0, 1), cA + hstep, voffA);
        if (wr == 1) PG8_BAR;
        PG8_WAIT_V(2); PG8_BAR;
        PG8_STAGE(PG8_SB(1, 0), cB + kstep, voffB); PG8_STAGE(PG8_SA(1, 0), cA + kstep, voffA); PG8_STAGE(PG8_SB(1, 1), cB + hstep + kstep, voffB);
        PG8_WAIT_V(6); PG8_BAR;
    } else {
        PG8_STAGE(PG8_SB(0, 0), cB, voffB); PG8_STAGE(PG8_SA(0, 0), cA, voffA); PG8_STAGE(PG8_SB(0, 1), cB + hstep, voffB); PG8_STAGE(PG8_SA(0, 1), cA + hstep, voffA);
        if (wr == 1) PG8_BAR;
        PG8_WAIT_V(4); PG8_BAR;
        PG8_STAGE(PG8_SB(1, 0), cB + kstep, voffB); PG8_STAGE(PG8_SA(1, 0), cA + kstep, voffA); PG8_STAGE(PG8_SB(1, 1), cB + hstep + kstep, voffB);
        PG8_WAIT_V(6); PG8_BAR;
    }
    for (;;) {
        const bool has_next = S.next(ui + 1, nxt);
        const char* nA = has_next ? (const char*)g.A + (size_t)nxt.pm * tstep : cA; const char* nB = has_next ? (const char*)g.Bt + (size_t)nxt.pn * tstep : cB;
        for (int t = 0; t < nt; t += 2) {
            const bool last = (t == nt - 2);
            const char* a1 = cA + (size_t)(t + 1) * kstep;
            const char* a2 = last ? nA : cA + (size_t)(t + 2) * kstep; const char* b2 = last ? nB : cB + (size_t)(t + 2) * kstep;
            const char* a3 = a2 + kstep; const char* b3 = b2 + kstep;
            if (last && has_next) S.a_ready(nxt);
            if constexpr (SP2) {
            PG8_LDB(B0, 0, 0); PG8_LDB(B1, 0, 1); PG8_SCHED; PG8_LDA(At, 0, 0); PG8_STAGE(PG8_SA(1, 1), a1 + hstep, voffA);
            PG8_WAIT_V(8); PG8_WAIT_L(0); PG8_BAR; PG8_MMA(0, 0, At, B0); PG8_MMA(0, 1, At, B1); PG8_BAR; PG8_SCHED;
            PG8_LDA(At, 0, 1); PG8_STAGE(PG8_SB(0, 0), b2, voffB); PG8_STAGE(PG8_SB(0, 1), b2 + hstep, voffB); PG8_STAGE(PG8_SA(0, 0), a2, voffA);
            PG8_WAIT_V(8); PG8_WAIT_L(0); PG8_BAR; PG8_MMA(1, 0, At, B0); PG8_MMA(1, 1, At, B1); PG8_BAR; PG8_SCHED;
            PG8_LDB(B0, 1, 0); PG8_LDB(B1, 1, 1); PG8_SCHED; PG8_LDA(At, 1, 0); PG8_STAGE(PG8_SA(0, 1), a2 + hstep, voffA);
            PG8_WAIT_V(8); PG8_WAIT_L(0); PG8_BAR; PG8_MMA(0, 0, At, B0); PG8_MMA(0, 1, At, B1); PG8_BAR; PG8_SCHED;
            PG8_LDA(At, 1, 1); PG8_STAGE(PG8_SB(1, 0), b3, voffB); PG8_STAGE(PG8_SB(1, 1), b3 + hstep, voffB); PG8_STAGE(PG8_SA(1, 0), a3, voffA);
            PG8_WAIT_V(8); PG8_WAIT_L(0); PG8_BAR; PG8_MMA(1, 0, At, B0); PG8_MMA(1, 1, At, B1); PG8_BAR; PG8_SCHED;
            } else {
            PG8_LDB(B0, 0, 0); PG8_SCHED; PG8_LDA(At, 0, 0); PG8_STAGE(PG8_SA(1, 1), a1 + hstep, voffA);
            PG8_WAIT_L(8); PG8_BAR; PG8_WAIT_L(0); PG8_MMA(0, 0, At, B0); PG8_BAR; PG8_SCHED;
            PG8_LDB(B1, 0, 1); PG8_STAGE(PG8_SB(0, 0), b2, voffB);
            PG8_BAR; PG8_WAIT_L(0); PG8_MMA(0, 1, At, B1); PG8_BAR;
            PG8_LDA(At, 0, 1); PG8_STAGE(PG8_SA(0, 0), a2, voffA);
            PG8_BAR; PG8_WAIT_L(0); PG8_MMA(1, 0, At, B0); PG8_BAR; PG8_SCHED;
            PG8_STAGE(PG8_SB(0, 1), b2 + hstep, voffB);
            PG8_WAIT_V(6); PG8_BAR; PG8_MMA(1, 1, At, B1); PG8_BAR;
            PG8_LDB(B0, 1, 0); PG8_SCHED; PG8_LDA(At, 1, 0); PG8_STAGE(PG8_SA(0, 1), a2 + hstep, voffA);
            PG8_WAIT_L(8); PG8_BAR; PG8_WAIT_L(0); PG8_MMA(0, 0, At, B0); PG8_BAR; PG8_SCHED;
            PG8_LDB(B1, 1, 1); PG8_STAGE(PG8_SB(1, 0), b3, voffB);
            PG8_BAR; PG8_WAIT_L(0); PG8_MMA(0, 1, At, B1); PG8_BAR;
            PG8_LDA(At, 1, 1); PG8_STAGE(PG8_SA(1, 0), a3, voffA);
            PG8_BAR; PG8_WAIT_L(0); PG8_MMA(1, 0, At, B0); PG8_BAR; PG8_SCHED;
            PG8_STAGE(PG8_SB(1, 1), b3 + hstep, voffB);
            PG8_WAIT_V(6); PG8_BAR; PG8_MMA(1, 1, At, B1); PG8_BAR;
            }
        }
        if constexpr (ALIGN_EPI) { if (wr == 0) PG8_BAR; }
        if constexpr (!Epi::AFTER_DRAIN) { E(acc, cur, wr, wc, fr, fq); S.done(cur); }
        if (!has_next) break;
#pragma unroll
        for (int a = 0; a < 2; ++a)
#pragma unroll
            for (int b = 0; b < 2; ++b)
#pragma unroll
                for (int m = 0; m < 4; ++m)
#pragma unroll
                    for (int n = 0; n < 2; ++n) acc[a][b][m][n] = (f32x4){0.f, 0.f, 0.f, 0.f};
        cur = nxt; cA = nA; cB = nB; ++ui;
        if constexpr (ALIGN_EPI) { if (wr == 1) PG8_BAR; }
    }
    PG8_WAIT_V(0);
    if constexpr (!ALIGN_EPI) { if (wr == 0) PG8_BAR; }
    PG8_BAR;
    if constexpr (Epi::AFTER_DRAIN) { E.fused(acc, cur, wr, wc, fr, fq, lds, wid, lane); S.done(cur); }
#undef PG8_SA
#undef PG8_SB
#undef PG8_STAGE
#undef PG8_LDA
#undef PG8_LDB
#undef PG8_MMA
#undef PG8_WAIT_V
#undef PG8_WAIT_L
#undef PG8_BAR
#undef PG8_SCHED
}
}
#define GAS __attribute__((address_space(1)))
#define LAS __attribute__((address_space(3)))
typedef unsigned short bf16;
typedef unsigned v4u __attribute__((ext_vector_type(4)));
typedef float f32x4 __attribute__((ext_vector_type(4)));
typedef short bf16x8 __attribute__((ext_vector_type(8)));
typedef GAS unsigned gu32;
typedef GAS unsigned long long gu64;
#define RLX_AGENT __ATOMIC_RELAXED, __HIP_MEMORY_SCOPE_AGENT
#define LDS_WAIT() asm volatile("s_waitcnt lgkmcnt(0)" ::: "memory")
#define VM_WAIT() asm volatile("s_waitcnt vmcnt(0)" ::: "memory")
__device__ __forceinline__ unsigned long long rt() { return __builtin_amdgcn_s_memrealtime(); }
__device__ __forceinline__ unsigned f2bf(float f) { unsigned u = __builtin_bit_cast(unsigned, f); return (u + 0x7fffu + ((u >> 16) & 1u)) >> 16; }
__device__ __forceinline__ unsigned pk2(float lo, float hi) { return f2bf(lo) | (f2bf(hi) << 16); }
#define XB_TMO      128
#define XB_XCNT(j)  (256  + 64 * (j))
#define XB_XSUB(j)  (1280 + 64 * (j))
#define XB_XGEN(j)  (2304 + 64 * (j))
#define XB_TOP      3328
#define XB_TOPGEN   3392
#define XCD_BAR_WORDS 3456
#define XB_SPIN_CAP (1u << 18)

__device__ __forceinline__ unsigned xb_ld(unsigned* p)              { return __hip_atomic_load(p, __ATOMIC_RELAXED, __HIP_MEMORY_SCOPE_AGENT); }
__device__ __forceinline__ unsigned xb_add(unsigned* p, unsigned v) { return __hip_atomic_fetch_add(p, v, __ATOMIC_RELAXED, __HIP_MEMORY_SCOPE_AGENT); }
__device__ __forceinline__ unsigned xb_xcc_id() { return (unsigned)__builtin_amdgcn_s_getreg((3 << 11) | 20) & 0xFu; }
#define XB_SPIN(cond, bar) do { unsigned _sp = 0; while (cond) { __builtin_amdgcn_s_sleep(1); \
    if ((++_sp & 255u) == 0u) { if (xb_ld(&(bar)[XB_TMO])) break; if (_sp > XB_SPIN_CAP) { atomicAdd(&(bar)[XB_TMO], 1u); break; } } } } while (0)

struct XcdBarrier {
    unsigned* bar; unsigned x;
    volatile LAS unsigned* st;
};

__device__ __forceinline__ XcdBarrier xcd_barrier_post(unsigned* bar, volatile LAS unsigned* st) {
    XcdBarrier b; b.bar = bar; b.x = xb_xcc_id(); b.st = st;
    if (threadIdx.x == 0) (void)xb_add(&bar[XB_XCNT(b.x)], 1u);
    return b;
}
__device__ __forceinline__ void xcd_barrier_complete(unsigned* bar, unsigned x, unsigned& nloc, unsigned& nx) {
    const unsigned G = gridDim.x * gridDim.y * gridDim.z;
    unsigned sum, cnt, mine, sp = 0u;
    for (;;) {
        sum = 0u; cnt = 0u; mine = 0u;
#pragma unroll
        for (unsigned j = 0; j < 16; ++j) { const unsigned c = xb_ld(&bar[XB_XCNT(j)]); sum += c; cnt += (c > 0u) ? 1u : 0u; mine = (j == x) ? c : mine; }
        if (sum == G) break;
        __builtin_amdgcn_s_sleep(1);
        if ((++sp & 255u) == 0u) { if (xb_ld(&bar[XB_TMO])) break; if (sp > XB_SPIN_CAP) { atomicAdd(&bar[XB_TMO], 1u); break; } }
    }
    nloc = mine > 0u ? mine : 1u; nx = cnt > 0u ? cnt : 1u;
}

__device__ __forceinline__ void xcd_barrier(const XcdBarrier& b) {
    asm volatile("s_waitcnt vmcnt(0)" ::: "memory");
    __syncthreads();
    if (threadIdx.x == 0) {
        unsigned* bar = b.bar;
        __builtin_amdgcn_s_waitcnt(0);
        unsigned nloc = b.st[0], nx = b.st[1];
        if (nloc == 0u) { xcd_barrier_complete(bar, b.x, nloc, nx); b.st[0] = nloc; b.st[1] = nx; }
        const unsigned old = xb_add(&bar[XB_XSUB(b.x)], 1u);
        const unsigned gen = old / nloc;
        if (old + 1u == (gen + 1u) * nloc) {
            __builtin_amdgcn_fence(__ATOMIC_RELEASE, "agent");
            asm volatile("s_waitcnt vmcnt(0)" ::: "memory");
            const unsigned og = xb_add(&bar[XB_TOP], 1u);
            const unsigned tg = og / nx;
            if (og + 1u == (tg + 1u) * nx) xb_add(&bar[XB_TOPGEN], 1u);
            else XB_SPIN(xb_ld(&bar[XB_TOPGEN]) == tg, bar);
            __builtin_amdgcn_fence(__ATOMIC_ACQUIRE, "agent");
            xb_add(&bar[XB_XGEN(b.x)], 1u);
            asm volatile("s_waitcnt vmcnt(0)" ::: "memory");
        } else {
            XB_SPIN(xb_ld(&bar[XB_XGEN(b.x)]) == gen, bar);
            __builtin_amdgcn_fence(__ATOMIC_ACQUIRE, "agent");
            asm volatile("s_waitcnt vmcnt(0)" ::: "memory");
        }
    }
    __syncthreads();
}

constexpr int NWAVES = 8;
constexpr int BATCH = 2, T = 8192, D = 1024, M = BATCH * T, FF = 2816, NFF2 = 2 * FF;
constexpr int MLH = 4, MLD = 128, MLW = 512, NAH = 8, NAD = 64, NG = 16, DIN = 3088, NPROJ = 3072;
constexpr int GW = 64, GROWS = T / GW;
constexpr int PC_C = 0, PC_V = 512, PC_O = 1024, PC_QN = 1536, PC_KN = 2048, PC_VN = 2560;
constexpr float EPS = 1e-6f;

constexpr size_t MiB = 1u << 20;
constexpr size_t WS_CTL = 0, CTL_ZERO_BYTES = 1 * MiB;
constexpr size_t WS_W1T = 2 * MiB;
constexpr size_t WS_W1DT = 13 * MiB;
constexpr size_t WS_WINT = 19 * MiB;
constexpr size_t WS_WOUTT = 25 * MiB;
constexpr size_t WS_W2T = 27 * MiB;
constexpr size_t WS_W2DT = 38 * MiB;
constexpr size_t WS_WG = 45 * MiB;
constexpr size_t WS_SS = 46 * MiB;
constexpr size_t WS_GATES = 47 * MiB;
constexpr size_t WS_XB = 50 * MiB;
constexpr size_t WS_HP = 82 * MiB;
constexpr size_t WS_Y = 178 * MiB;
constexpr size_t WS_HS = 210 * MiB;
constexpr size_t WS_END = 256 * MiB;
constexpr int CW_TMO = 0, CW_CODE = 1, CW_BAR = 4096;

constexpr int RING_OFF = 0, RING_BYTES = 131072;
constexpr int LDSCTL_OFF = RING_BYTES, MISC_OFF = LDSCTL_OFF + 320;
constexpr int LDS_BYTES = 147456;

__device__ __forceinline__ float wave_sum(float v) {
#pragma unroll
    for (int o = 1; o < 64; o <<= 1) v += __shfl_xor(v, o);
    return v;
}
__device__ __forceinline__ float wave_max(float v) {
#pragma unroll
    for (int o = 1; o < 64; o <<= 1) v = fmaxf(v, __shfl_xor(v, o));
    return v;
}
__device__ __forceinline__ float bf2f(bf16 v) { return __builtin_bit_cast(float, (unsigned)v << 16); }

__device__ __forceinline__ void transpose_item(const float* W, int ldw, int k0, int nsrc0, const float* gain, bf16* WT, int K, int dstrow0, LAS float* scr, int lane) {
#pragma unroll 8
    for (int i = 0; i < 32; ++i) { const int kk = 2 * i + (lane >> 5); float v = W[(size_t)(k0 + kk) * ldw + nsrc0 + (lane & 31)]; if (gain) v *= gain[k0 + kk]; scr[kk * 33 + (lane & 31)] = v; }
    LDS_WAIT(); asm volatile("" ::: "memory");
    const int c = lane & 7;
#pragma unroll
    for (int j = 0; j < 4; ++j) { const int n = (lane >> 3) + 8 * j; const LAS float* s = scr + (8 * c) * 33 + n;
        v4u o; o.x = pk2(s[0 * 33], s[1 * 33]); o.y = pk2(s[2 * 33], s[3 * 33]); o.z = pk2(s[4 * 33], s[5 * 33]); o.w = pk2(s[6 * 33], s[7 * 33]);
        *(GAS v4u*)(WT + (size_t)(dstrow0 + n) * K + k0 + 8 * c) = o; }
    LDS_WAIT(); asm volatile("" ::: "memory");
}

struct Ptrs {
    const float *x, *g1, *w1g, *w1u, *w1d, *gm, *win, *bg, *cw, *cb, *wq, *wk, *gn, *gq, *gk, *rpb, *wout, *g2, *w2g, *w2u, *w2d, *gf;
    float* out;
    bf16 *W1T, *W1DT, *WINT, *WOUTT, *W2T, *W2DT, *XB, *QB, *KB, *H, *PROJ, *Y, *HSF, *HSB;
    float *WG, *SS, *GATES;
};

__device__ __forceinline__ void p0_prologue(const Ptrs& P, LAS unsigned char* lds, int gw, int NGW, int lane, int wave, int gtid, int NGT) {
    LAS float* scr = (LAS float*)(lds + RING_OFF + wave * 16384);
    constexpr int I_GU = 16 * 88, I_DN = 44 * 32, I_IN = 16 * 96, I_OUT = 16 * 32;
    constexpr int NITEMS = 2 * (2 * I_GU + I_DN) + I_IN + I_OUT;
    for (int it = gw; it < NITEMS; it += NGW) {
        int r = it;
        if (r < 2 * (2 * I_GU + I_DN)) {
            const bool second = r >= (2 * I_GU + I_DN); if (second) r -= (2 * I_GU + I_DN);
            const float* wg = second ? P.w2g : P.w1g; const float* wu = second ? P.w2u : P.w1u; const float* wd = second ? P.w2d : P.w1d; const float* gain = second ? P.g2 : P.g1;
            bf16* WT = second ? P.W2T : P.W1T; bf16* WDT = second ? P.W2DT : P.W1DT;
            if (r < 2 * I_GU) { const bool up = r >= I_GU; if (up) r -= I_GU; const int kb = r / 88, nb = r % 88, n0 = 32 * nb, dst = 256 * (n0 >> 7) + (n0 & 127) + (up ? 128 : 0);
                transpose_item(up ? wu : wg, FF, 64 * kb, n0, gain, WT, D, dst, scr, lane); }
            else { r -= 2 * I_GU; const int kb = r / 32, nb = r % 32; transpose_item(wd, D, 64 * kb, 32 * nb, nullptr, WDT, FF, 32 * nb, scr, lane); }
            continue;
        }
        r -= 2 * (2 * I_GU + I_DN);
        if (r < I_IN) { const int kb = r / 96, nb = r % 96, nd = 32 * nb, ns = nd < 1536 ? nd : nd + 16; transpose_item(P.win, DIN, 64 * kb, ns, P.gm, P.WINT, D, nd, scr, lane); continue; }
        r -= I_IN;
        { const int kb = r / 32, nb = r % 32; transpose_item(P.wout, D, 64 * kb, 32 * nb, nullptr, P.WOUTT, D, 32 * nb, scr, lane); }
    }
    for (int i = gtid; i < NG * D; i += NGT) { const int j = i >> 10, k = i & 1023; P.WG[i] = P.gm[k] * P.win[(size_t)k * DIN + 1536 + j]; }
    for (int m = gw; m < M; m += NGW) {
        const GAS f32x4* xr = (const GAS f32x4*)(P.x + (size_t)m * D) + lane;
        f32x4 v[4]; float s = 0.f;
#pragma unroll
        for (int j = 0; j < 4; ++j) { v[j] = xr[64 * j]; s += (v[j].x * v[j].x + v[j].y * v[j].y) + (v[j].z * v[j].z + v[j].w * v[j].w); }
        s = wave_sum(s);
        GAS unsigned long long* o8 = (GAS unsigned long long*)(P.XB + (size_t)m * D) + lane;
#pragma unroll
        for (int j = 0; j < 4; ++j) o8[64 * j] = (unsigned long long)pk2(v[j].x, v[j].y) | ((unsigned long long)pk2(v[j].z, v[j].w) << 32);
        if (lane < 16) P.SS[(size_t)m * 16 + lane] = lane == 0 ? s : 0.f;
    }
}

__device__ __forceinline__ void gates_naive(const Ptrs& P, int gw, int NGW, int lane) {
    for (int m = gw; m < M; m += NGW) {
        const GAS f32x4* xr = (const GAS f32x4*)(P.out + (size_t)m * D) + lane;
        f32x4 v[4]; float s = 0.f;
#pragma unroll
        for (int j = 0; j < 4; ++j) { v[j] = xr[64 * j]; s += (v[j].x * v[j].x + v[j].y * v[j].y) + (v[j].z * v[j].z + v[j].w * v[j].w); }
        s = wave_sum(s);
        const float rs = 1.0f / sqrtf(s * (1.0f / D) + EPS);
        float mine = 0.f;
        for (int g = 0; g < NG; ++g) {
            const GAS f32x4* wr = (const GAS f32x4*)(P.WG + (size_t)g * D) + lane; float d = 0.f;
#pragma unroll
            for (int j = 0; j < 4; ++j) { const f32x4 w = wr[64 * j]; d += (v[j].x * w.x + v[j].y * w.y) + (v[j].z * w.z + v[j].w * w.w); }
            d = wave_sum(d);
            if (lane == g) mine = d;
        }
        if (lane < NG) P.GATES[(size_t)m * NG + lane] = rs * mine + P.bg[lane];
    }
}

__device__ __forceinline__ void ml_pre_naive(const Ptrs& P, LAS unsigned char* lds, int vcu, int G, int tid) {
    LAS float* U = (LAS float*)(lds + RING_OFF);
    for (int grp = vcu; grp < M / 16; grp += G) {
        const int row0 = grp * 16, b = row0 / T, t0 = row0 % T;
        { const int ch = tid; float w[5]; for (int j = 0; j < 5; ++j) w[j] = P.cw[j * MLW + ch]; const float cbv = P.cb[ch];
          float win[20];
#pragma unroll
          for (int i = 0; i < 20; ++i) { const int t = t0 + i - 2; win[i] = (t >= 0 && t < T) ? bf2f(P.PROJ[(size_t)(b * T + t) * NPROJ + PC_C + ch]) : 0.f; }
#pragma unroll
          for (int i = 0; i < 16; ++i) { float y = cbv;
#pragma unroll
              for (int j = 0; j < 5; ++j) y += win[i + j] * w[j];
              U[i * 512 + ch] = y / (1.0f + __expf(-y)); } }
        __syncthreads();
        { const int e = tid & 127, hh = tid >> 7; float aq[16], ak[16];
#pragma unroll
          for (int i = 0; i < 16; ++i) { aq[i] = 0.f; ak[i] = 0.f; }
          for (int d = 0; d < MLD; ++d) { const float wq = P.wq[(size_t)(hh * MLD + d) * MLD + e], wk = P.wk[(size_t)(hh * MLD + d) * MLD + e];
#pragma unroll
              for (int i = 0; i < 16; ++i) { const float u = U[i * 512 + hh * MLD + d]; aq[i] += u * wq; ak[i] += u * wk; } }
#pragma unroll
          for (int i = 0; i < 16; ++i) { P.QB[(size_t)(row0 + i) * MLW + hh * MLD + e] = (bf16)f2bf(aq[i]); P.KB[(size_t)(row0 + i) * MLW + hh * MLD + e] = (bf16)f2bf(ak[i] * 0.08838834764831845f); } }
        __syncthreads();
    }
}

__device__ __forceinline__ float logsigmoidf(float x) { return fminf(x, 0.f) - log1pf(__expf(-fabsf(x))); }

__device__ __forceinline__ void ml_rec_naive(const Ptrs& P, LAS unsigned char* lds, int blk, int tid) {
    constexpr int CH = 16, STR = 400, KO = 0, QO = 132, VO = 264, GO = 396;
    LAS float* buf = (LAS float*)(lds + RING_OFF);
    LAS float* dens = buf + 2 * CH * STR;
    const int dir = blk >> 3, b = (blk >> 2) & 1, hh = blk & 3;
    bf16* HS = dir ? P.HSB : P.HSF;
    const int d = tid >> 2, eq = tid & 3, e0 = eq * 32;
    float C[32], nn[32]; float m = 0.f;
#pragma unroll
    for (int j = 0; j < 32; ++j) { C[j] = 0.f; nn[j] = 0.f; }
    float pre[CH]; float preg = 0.f;
    const int wh = tid >> 7, el = tid & 127;
    const bf16* src = wh == 0 ? P.KB + hh * MLD + el : wh == 1 ? P.QB + hh * MLD + el : P.PROJ + PC_V + hh * MLD + el;
    const long pitch = wh < 2 ? MLW : NPROJ, sstep = dir ? -pitch : pitch;
    const bf16* src0 = src + (size_t)(b * T + (dir ? T - 1 : 0)) * pitch;
    const float* gsrc0 = P.GATES + (size_t)(b * T + (dir ? T - 1 : 0)) * NG + dir * 8 + (tid & 1) * 4 + hh; const long gstep = dir ? -NG : NG;
    auto rowof = [&](int gs) { const int t = dir ? (T - 1 - gs) : gs; return b * T + t; };
#define ML_LOAD(c) do { if (tid < 384) { const bf16* sp = src0 + (long)((c) * CH) * sstep; _Pragma("unroll") for (int r = 0; r < CH; ++r) pre[r] = bf2f(sp[r * sstep]); } \
        else if (tid < 416) { preg = gsrc0[(long)((c) * CH + ((tid - 384) >> 1)) * gstep]; } } while (0)
#define ML_STORE(c) do { LAS float* bb = buf + ((c) & 1) * CH * STR; if (tid < 384) { _Pragma("unroll") for (int r = 0; r < CH; ++r) bb[r * STR + wh * 132 + el + (el >> 5)] = pre[r]; } \
        else if (tid < 416) bb[((tid - 384) >> 1) * STR + GO + (tid & 1)] = preg; } while (0)
    ML_LOAD(0); ML_STORE(0); __syncthreads();
#pragma unroll 1
    for (int c = 0; c < T / CH; ++c) {
        if (c + 1 < T / CH) ML_LOAD(c + 1);
        const LAS float* bb = buf + (c & 1) * CH * STR;
#pragma unroll 1
        for (int st = 0; st < CH; ++st) {
            const LAS float* p = bb + st * STR; const int gs = c * CH + st;
            const float li = p[GO], lf = logsigmoidf(p[GO + 1]);
            const float mn = fmaxf(lf + m, li), a = __expf(lf + m - mn), bi = __expf(li - mn); m = mn;
            const float vd = p[VO + d + (d >> 5)] * bi; float part = 0.f;
#pragma unroll
            for (int j = 0; j < 32; ++j) { C[j] = a * C[j] + vd * p[KO + e0 + eq + j]; part += C[j] * p[QO + e0 + eq + j]; }
            part += __shfl_xor(part, 1); part += __shfl_xor(part, 2);
            if (tid < 4) { float dp = 0.f;
#pragma unroll
                for (int j = 0; j < 32; ++j) { nn[j] = a * nn[j] + bi * p[KO + e0 + eq + j]; dp += nn[j] * p[QO + e0 + eq + j]; }
                dp += __shfl_xor(dp, 1); dp += __shfl_xor(dp, 2);
                if (tid == 0) dens[gs & 1] = dp; }
            __syncthreads();
            const float den = dens[gs & 1]; const float h = part / fmaxf(fabsf(den), __expf(-m));
            if (eq == 0) HS[(size_t)rowof(gs) * MLW + hh * MLD + d] = (bf16)f2bf(h);
        }
        if (c + 1 < T / CH) ML_STORE(c + 1);
        __syncthreads();
    }
#undef ML_LOAD
#undef ML_STORE
}

__device__ __forceinline__ void ml_post_naive(const Ptrs& P, int gw, int NGW, int lane) {
    for (int it = gw; it < M * MLH; it += NGW) {
        const int row = it >> 2, hh = it & 3; const size_t o = (size_t)row * MLW + hh * MLD;
        float h0 = bf2f(P.HSF[o + lane]) + bf2f(P.HSB[o + lane]), h1 = bf2f(P.HSF[o + 64 + lane]) + bf2f(P.HSB[o + 64 + lane]);
        const float ms = wave_sum(h0 * h0 + h1 * h1) * (1.0f / MLD), rs = 1.0f / sqrtf(ms + EPS);
        const float o0 = bf2f(P.PROJ[(size_t)row * NPROJ + PC_O + hh * MLD + lane]), o1 = bf2f(P.PROJ[(size_t)row * NPROJ + PC_O + hh * MLD + 64 + lane]);
        P.Y[(size_t)row * D + hh * MLD + lane] = (bf16)f2bf(h0 * rs * P.gn[hh * MLD + lane] / (1.0f + __expf(-o0)));
        P.Y[(size_t)row * D + hh * MLD + 64 + lane] = (bf16)f2bf(h1 * rs * P.gn[hh * MLD + 64 + lane] / (1.0f + __expf(-o1)));
    }
}

__device__ __forceinline__ void na_naive(const Ptrs& P, int gw, int NGW, int lane) {
    for (int it = gw; it < M * NAH; it += NGW) {
        const int row = it >> 3, hd = it & 7, b = row / T, t = row % T, gr = t / GW, gc = t % GW;
        const int rs = min(max(gr - 4, 0), GROWS - 8), cs = min(max(gc - 8, 0), GW - 16);
        const float qv = bf2f(P.PROJ[(size_t)row * NPROJ + PC_QN + hd * NAD + lane]);
        const float qh = qv * (1.0f / sqrtf(wave_sum(qv * qv) * (1.0f / NAD) + EPS)) * P.gq[lane] * 0.125f;
        const float gkl = P.gk[lane];
        float s0 = 0.f, s1 = 0.f;
        for (int j = 0; j < 128; ++j) {
            const int i = j >> 4, w = j & 15; const size_t rk = (size_t)b * T + (rs + i) * GW + cs + w;
            const float kv = bf2f(P.PROJ[rk * NPROJ + PC_KN + hd * NAD + lane]);
            const float kh = kv * (1.0f / sqrtf(wave_sum(kv * kv) * (1.0f / NAD) + EPS)) * gkl;
            const int dr = rs + i - gr + 7, dc = cs + w - gc + 15;
            const float s = wave_sum(qh * kh) + P.rpb[(hd * 15 + dr) * 31 + dc];
            if (lane == (j & 63)) { if (j < 64) s0 = s; else s1 = s; }
        }
        const float mx = wave_max(fmaxf(s0, s1)); const float p0 = __expf(s0 - mx), p1 = __expf(s1 - mx); const float sum = wave_sum(p0 + p1);
        float acc = 0.f;
        for (int j = 0; j < 128; ++j) {
            const int i = j >> 4, w = j & 15; const size_t rk = (size_t)b * T + (rs + i) * GW + cs + w;
            const float pj = __shfl(j < 64 ? p0 : p1, j & 63);
            acc += pj * bf2f(P.PROJ[rk * NPROJ + PC_VN + hd * NAD + lane]);
        }
        P.Y[(size_t)row * D + MLW + hd * NAD + lane] = (bf16)f2bf(acc / sum);
    }
}

__device__ __forceinline__ void final_norm(const Ptrs& P, int gw, int NGW, int lane) {
    for (int m = gw; m < M; m += NGW) {
        const float rs = pg8::rstd_from_ss(P.SS, m);
        GAS f32x4* xr = (GAS f32x4*)(P.out + (size_t)m * D) + lane; const GAS f32x4* gr = (const GAS f32x4*)P.gf + lane;
#pragma unroll
        for (int j = 0; j < 4; ++j) { f32x4 v = xr[64 * j]; const f32x4 g = gr[64 * j]; v = v * rs * g; xr[64 * j] = v; }
    }
}

#define MAKE_P() Ptrs P; do { \
    P.x = args.in[0]; P.g1 = args.in[1]; P.w1g = args.in[2]; P.w1u = args.in[3]; P.w1d = args.in[4]; P.gm = args.in[5]; P.win = args.in[6]; P.bg = args.in[7]; P.cw = args.in[8]; P.cb = args.in[9]; \
    P.wq = args.in[10]; P.wk = args.in[11]; P.gn = args.in[12]; P.gq = args.in[13]; P.gk = args.in[14]; P.rpb = args.in[15]; P.wout = args.in[16]; P.g2 = args.in[17]; P.w2g = args.in[18]; P.w2u = args.in[19]; \
    P.w2d = args.in[20]; P.gf = args.in[21]; P.out = args.out; \
    P.W1T = (bf16*)(ws + WS_W1T); P.W1DT = (bf16*)(ws + WS_W1DT); P.WINT = (bf16*)(ws + WS_WINT); P.WOUTT = (bf16*)(ws + WS_WOUTT); P.W2T = (bf16*)(ws + WS_W2T); P.W2DT = (bf16*)(ws + WS_W2DT); \
    P.XB = (bf16*)(ws + WS_XB); P.QB = (bf16*)(ws + WS_XB); P.KB = (bf16*)(ws + WS_XB + 16 * MiB); P.H = (bf16*)(ws + WS_HP); P.PROJ = (bf16*)(ws + WS_HP); P.Y = (bf16*)(ws + WS_Y); \
    P.HSF = (bf16*)(ws + WS_HS); P.HSB = (bf16*)(ws + WS_HS + 16 * MiB); \
    P.WG = (float*)(ws + WS_WG); P.SS = (float*)(ws + WS_SS); P.GATES = (float*)(ws + WS_GATES); } while (0)
#ifndef MK_N_LAUNCHES
#define MK_N_LAUNCHES 1
#endif
constexpr int NPH = 11;
constexpr int N_LAUNCHES = MK_N_LAUNCHES;
struct Args { const float* in[22]; float* out; unsigned char* ws; int ph_lo, ph_hi; };
__global__ void __launch_bounds__(NWAVES * 64, 2) fwd_megakernel(Args args) {
    extern __shared__ __attribute__((aligned(16))) unsigned char lds_raw[];
    LAS unsigned char* lds = (LAS unsigned char*)lds_raw;
    volatile LAS unsigned* MISC = (volatile LAS unsigned*)(lds + MISC_OFF);
    const int tid = threadIdx.x, lane = tid & 63, wave = __builtin_amdgcn_readfirstlane(tid >> 6);
    const int G = gridDim.x, bx = blockIdx.x, vcu = (G % 8 == 0) ? (bx % 8) * (G / 8) + bx / 8 : bx;
    const int gw = vcu * NWAVES + wave, NGW = G * NWAVES, gtid = vcu * NWAVES * 64 + tid, NGT = G * NWAVES * 64;
    unsigned char* ws = args.ws;
    gu32* ctl = (gu32*)(ws + WS_CTL);
    for (int u = tid; u < (LDS_BYTES - LDSCTL_OFF) / 4; u += NWAVES * 64) ((LAS unsigned*)(lds + LDSCTL_OFF))[u] = 0u;
    __syncthreads();
    XcdBarrier bar; bar.bar = (unsigned*)(ctl + CW_BAR); bar.x = 0; bar.st = nullptr;
    if (N_LAUNCHES == 1) bar = xcd_barrier_post((unsigned*)(ctl + CW_BAR), MISC + 8);
#define GRID_BAR() do { if (N_LAUNCHES == 1) xcd_barrier(bar); } while (0)
    const int lo = args.ph_lo, hi = args.ph_hi;
#ifndef PHASE_MASK
#define PHASE_MASK 0xFFFF
#endif
#define IN(k) (((PHASE_MASK >> (k)) & 1) && lo <= (k) && (k) < hi)
#define BOTH(k) (IN(k) && IN((k) + 1))

    if (IN(0)) { MAKE_P(); p0_prologue(P, lds, gw, NGW, lane, wave, gtid, NGT); if (BOTH(0)) GRID_BAR(); }
    if (IN(1)) { MAKE_P(); pg8::Gemm g{P.XB, P.W1T, M, NFF2, D}; pg8::StaticOrder S; S.init(M, NFF2, G, bx); pg8::EpiSwiGLU E{P.H, FF, P.SS};
        pg8::gemm_phase<pg8::EpiSwiGLU, pg8::StaticOrder, true, true>(lds + RING_OFF, g, S, E); if (BOTH(1)) GRID_BAR(); }
    if (IN(2)) { MAKE_P(); pg8::Gemm g{P.H, P.W1DT, M, D, FF}; pg8::StaticOrder S; S.init(M, D, G, bx); pg8::EpiResid E{P.x, P.out, P.XB, P.SS, 0.5f, D};
        pg8::gemm_phase<pg8::EpiResid, pg8::StaticOrder, true, true>(lds + RING_OFF, g, S, E); if (BOTH(2)) GRID_BAR(); }
    if (IN(3)) { MAKE_P(); gates_naive(P, gw, NGW, lane);
        pg8::Gemm g{P.XB, P.WINT, M, NPROJ, D}; pg8::StaticOrder S; S.init(M, NPROJ, G, bx); pg8::EpiProj E{P.PROJ, NPROJ, P.SS};
        pg8::gemm_phase<pg8::EpiProj, pg8::StaticOrder, true, true>(lds + RING_OFF, g, S, E); if (BOTH(3)) GRID_BAR(); }
    if (IN(4)) { MAKE_P(); ml_pre_naive(P, lds, vcu, G, tid); na_naive(P, gw, NGW, lane); if (BOTH(4)) GRID_BAR(); }
    if (IN(5)) { MAKE_P(); if (vcu < 16) ml_rec_naive(P, lds, vcu, tid); if (BOTH(5)) GRID_BAR(); }
    if (IN(6)) { MAKE_P(); ml_post_naive(P, gw, NGW, lane); if (BOTH(6)) GRID_BAR(); }
    if (IN(7)) { MAKE_P(); pg8::Gemm g{P.Y, P.WOUTT, M, D, D}; pg8::StaticOrder S; S.init(M, D, G, bx); pg8::EpiResid E{P.out, P.out, P.XB, P.SS, 1.0f, D};
        pg8::gemm_phase<pg8::EpiResid, pg8::StaticOrder, true, true>(lds + RING_OFF, g, S, E); if (BOTH(7)) GRID_BAR(); }
    if (IN(8)) { MAKE_P(); pg8::Gemm g{P.XB, P.W2T, M, NFF2, D}; pg8::StaticOrder S; S.init(M, NFF2, G, bx); pg8::EpiSwiGLU E{P.H, FF, P.SS};
        pg8::gemm_phase<pg8::EpiSwiGLU, pg8::StaticOrder, true, true>(lds + RING_OFF, g, S, E); if (BOTH(8)) GRID_BAR(); }
    if (IN(9)) { MAKE_P(); pg8::Gemm g{P.H, P.W2DT, M, D, FF}; pg8::StaticOrder S; S.init(M, D, G, bx); pg8::EpiResid E{P.out, P.out, nullptr, P.SS, 0.5f, D};
        pg8::gemm_phase<pg8::EpiResid, pg8::StaticOrder, true, true>(lds + RING_OFF, g, S, E); if (BOTH(9)) GRID_BAR(); }
    if (IN(10)) { MAKE_P(); final_norm(P, gw, NGW, lane); }
#undef IN
#undef BOTH
#undef GRID_BAR
}

extern "C" void kernel_launch(void* const* d_in, const int* in_sizes, int n_in, void* d_out, int out_size, void* d_ws, size_t ws_size, hipStream_t stream) {
    static int grid = 0;
    if (grid == 0) {
        if (n_in != 22 || in_sizes[0] != M * D || out_size != M * D || ws_size < WS_END) { fprintf(stderr, "kernel_launch: unexpected shapes (n_in %d, in0 %d, out %d, ws %zu)\n", n_in, n_in > 0 ? in_sizes[0] : -1, out_size, ws_size); grid = -1; return; }
        int dev = 0, cus = 0, per_cu = 0;
        if (hipGetDevice(&dev) != hipSuccess || hipDeviceGetAttribute(&cus, hipDeviceAttributeMultiprocessorCount, dev) != hipSuccess) { grid = -1; return; }
        if (hipFuncSetAttribute((const void*)fwd_megakernel, hipFuncAttributeMaxDynamicSharedMemorySize, LDS_BYTES) != hipSuccess) { fprintf(stderr, "kernel_launch: hipFuncSetAttribute failed\n"); grid = -1; return; }
        if (hipOccupancyMaxActiveBlocksPerMultiprocessor(&per_cu, (const void*)fwd_megakernel, NWAVES * 64, LDS_BYTES) != hipSuccess || per_cu < 1) { fprintf(stderr, "kernel_launch: occupancy query says %d blocks per CU\n", per_cu); per_cu = 1; }
        (void)hipGetLastError();
        grid = cus;
    }
    if (grid < 0) return;
    (void)hipMemsetAsync((char*)d_ws + WS_CTL, 0, CTL_ZERO_BYTES, stream);
    Args a{};
    for (int i = 0; i < 22; ++i) a.in[i] = (const float*)d_in[i];
    a.out = (float*)d_out; a.ws = (unsigned char*)d_ws;
    if (N_LAUNCHES == 1) { a.ph_lo = 0; a.ph_hi = NPH; hipLaunchKernelGGL(fwd_megakernel, dim3(grid), dim3(NWAVES * 64), LDS_BYTES, stream, a); }
    else for (int li = 0; li < NPH; ++li) { a.ph_lo = li; a.ph_hi = li + 1; hipLaunchKernelGGL(fwd_megakernel, dim3(grid), dim3(NWAVES * 64), LDS_BYTES, stream, a); }
}
```

```cpp
#include <hip/hip_runtime.h>
#include <cstdio>
#include <cstdint>
namespace pg8 {
#define PG8_LAS __attribute__((address_space(3)))
typedef unsigned short bf16_t;
typedef short bf16x8 __attribute__((ext_vector_type(8)));
typedef float f32x4 __attribute__((ext_vector_type(4)));
typedef unsigned u32x4 __attribute__((ext_vector_type(4)));
constexpr int BM = 256, BK = 64, HALF = 128, HTB = HALF * BK * 2  , STAGE_BYTES = 8 * HTB, NXCD = 8, WGM = 8;

__host__ __device__ __forceinline__ int lds_byte(int r, int c) { const int st = (r >> 4) * 2 + (c >> 5), rr = r & 15, cc = c & 31, ob = rr * 64 + cc * 2; return st * 1024 + (ob ^ (((ob >> 9) & 1) << 5)); }
__host__ __device__ __forceinline__ void stage_rc(int b, int& R, int& C) { const int st = b / 1024, sb = b % 1024, swz = sb ^ (((sb >> 9) & 1) << 5); R = (st >> 1) * 16 + swz / 64; C = (st & 1) * 32 + (swz % 64) / 2; }
__host__ __device__ __forceinline__ int perm32(int rho) { const int n = rho >> 4, i = rho & 15; return 8 * (i >> 2) + 4 * n + (i & 3); }

struct Unit { int pm, pn; };
struct Gemm { const bf16_t* A; const bf16_t* Bt; int M, N, K; };

struct StaticOrder {
    int nM, nN, nwg, G, c; bool tied; int pm0, pn0;
    __host__ __device__ void init(int M, int N, int G_, int c_) { nM = M / BM; nN = N / BM; nwg = nM * nN; G = G_; c = c_;
        tied = (G == 256 && nM == 64); pm0 = 8 * (c % 8) + (c / 8) % 8; pn0 = c >> 6; }
    __host__ __device__ bool next(int i, Unit& u) const {
        if (tied) { if (256 * i + c >= nwg) return false; u.pm = pm0; u.pn = 4 * i + pn0; return true; }
        const long L = (long)i * G + c; if (L >= nwg) return false;
        int wgid = (int)L; { const int q = nwg / NXCD, r = nwg % NXCD, xcd = wgid % NXCD, off = wgid / NXCD; wgid = (xcd < r ? xcd * (q + 1) : r * (q + 1) + (xcd - r) * q) + off; }
        const int nig = WGM * nN, gid = wgid / nig, fm = gid * WGM, gsz = (nM - fm) < WGM ? (nM - fm) : WGM;
        u.pm = fm + ((wgid % nig) % gsz); u.pn = (wgid % nig) / gsz; return true;
    }
    __device__ __forceinline__ void a_ready(const Unit&) const {}
    __device__ __forceinline__ void done(const Unit&) const {}
};

typedef float f32x2 __attribute__((ext_vector_type(2))); typedef __bf16 bf16x2v __attribute__((ext_vector_type(2)));
__device__ __forceinline__ unsigned cvt_pk_bf16(float lo, float hi) { f32x2 v = {lo, hi}; bf16x2v b = __builtin_convertvector(v, bf16x2v); return __builtin_bit_cast(unsigned, b); }
constexpr float RMS_EPS = 1e-6f;
__device__ __forceinline__ float rstd_from_ss(const float* ss, int row) {
    const f32x4* p = (const f32x4*)(ss + (size_t)row * 16);
    const f32x4 a = p[0], b = p[1], c = p[2], d = p[3];
    const float s = ((a[0] + a[1]) + (a[2] + a[3])) + ((b[0] + b[1]) + (b[2] + b[3])) + ((c[0] + c[1]) + (c[2] + c[3])) + ((d[0] + d[1]) + (d[2] + d[3]));
    return __builtin_amdgcn_rsqf(s * (1.0f / 1024.0f) + RMS_EPS);
}
__device__ __forceinline__ float rstd_from_ss4(const float* ss, int row, int fq) {
    const f32x4 a = *(const f32x4*)(ss + (size_t)row * 16 + 4 * fq);
    float s = (a[0] + a[1]) + (a[2] + a[3]); s += __shfl_xor(s, 16); s += __shfl_xor(s, 32);
    return __builtin_amdgcn_rsqf(s * (1.0f / 1024.0f) + RMS_EPS);
}
__device__ __forceinline__ f32x2 silu_mul2(f32x2 g, f32x2 u) {
    const f32x2 t = g * -1.4426950408889634f; f32x2 e; e.x = __builtin_amdgcn_exp2f(t.x); e.y = __builtin_amdgcn_exp2f(t.y);
    const f32x2 d = e + 1.0f; f32x2 r; r.x = __builtin_amdgcn_rcpf(d.x); r.y = __builtin_amdgcn_rcpf(d.y);
    return (g * r) * u;
}
struct EpiSwiGLU {
    static constexpr bool PERM = true, AFTER_DRAIN = false, INIT = false, LDSBASE = false;
    bf16_t* H; int ldh; const float* ss; const PG8_LAS float* rt;
    __device__ __forceinline__ void operator()(const f32x4 (&acc)[2][2][4][2], const Unit& u, int wr, int wc, int fr, int fq) const {
        const int row0 = u.pm * BM + wr * 64 + fr, col0 = u.pn * HALF + wc * 32 + 8 * fq;
        float rsv[8];
#pragma unroll
        for (int k = 0; k < 8; ++k) rsv[k] = rt[(row0 + (k >> 2) * HALF + (k & 3) * 16) & 255];
#pragma unroll
        for (int ai = 0; ai < 2; ++ai)
#pragma unroll
            for (int m = 0; m < 4; ++m) { const int row = row0 + ai * HALF + m * 16; const float rs = rsv[ai * 4 + m];
                const f32x4 g0 = acc[ai][0][m][0] * rs, g1 = acc[ai][0][m][1] * rs, u0 = acc[ai][1][m][0] * rs, u1 = acc[ai][1][m][1] * rs;
                const f32x2 h0 = silu_mul2((f32x2){g0[0], g0[1]}, (f32x2){u0[0], u0[1]}), h1 = silu_mul2((f32x2){g0[2], g0[3]}, (f32x2){u0[2], u0[3]});
                const f32x2 h2 = silu_mul2((f32x2){g1[0], g1[1]}, (f32x2){u1[0], u1[1]}), h3 = silu_mul2((f32x2){g1[2], g1[3]}, (f32x2){u1[2], u1[3]});
                u32x4 w; w.x = cvt_pk_bf16(h0.x, h0.y); w.y = cvt_pk_bf16(h1.x, h1.y); w.z = cvt_pk_bf16(h2.x, h2.y); w.w = cvt_pk_bf16(h3.x, h3.y);
                *(u32x4*)(H + (size_t)row * ldh + col0) = w; }
    }
};
__device__ __forceinline__ u32x4 lds_resid8(const PG8_LAS unsigned char* lds, int ai, int bj, int wr, int wc, int m, int fr, int fq) {
    const int hi = wc >> 1, slot = bj == 0 ? 4 + 2 * ai + hi : (ai == 0 ? hi : (hi ? 8 : 2));
    return *(const PG8_LAS u32x4*)(lds + slot * HTB + lds_byte(wr * 64 + m * 16 + fr, (wc & 1) * 32 + fq * 8));
}
__device__ __forceinline__ void add_resid(f32x4 (&acc)[2][2][4][2], float alpha, const PG8_LAS unsigned char* lds, int wr, int wc, int fr, int fq) {
#pragma unroll
    for (int ai = 0; ai < 2; ++ai)
#pragma unroll
        for (int m = 0; m < 4; ++m)
#pragma unroll
            for (int bj = 0; bj < 2; ++bj) { const u32x4 w = lds_resid8(lds, ai, bj, wr, wc, m, fr, fq); f32x4 b0, b1;
                b0[0] = __builtin_bit_cast(float, w.x << 16); b0[1] = __builtin_bit_cast(float, w.x & 0xffff0000u); b0[2] = __builtin_bit_cast(float, w.y << 16); b0[3] = __builtin_bit_cast(float, w.y & 0xffff0000u);
                b1[0] = __builtin_bit_cast(float, w.z << 16); b1[1] = __builtin_bit_cast(float, w.z & 0xffff0000u); b1[2] = __builtin_bit_cast(float, w.w << 16); b1[3] = __builtin_bit_cast(float, w.w & 0xffff0000u);
                acc[ai][bj][m][0] = acc[ai][bj][m][0] * alpha + b0; acc[ai][bj][m][1] = acc[ai][bj][m][1] * alpha + b1; }
}
template <bool BASEBF, bool OUTF32, bool OUTBF, bool FUSENORM = false, int ALPHA2 = 2> struct EpiResid {
    static constexpr bool PERM = true, AFTER_DRAIN = true, INIT = false, LDSBASE = true;
    static_assert(BASEBF, "the residual stream is bf16");
    __device__ __forceinline__ const char* base_ptr() const { return (const char*)base; }
    const void* base; float* out; bf16_t* xb; float* ss; float alpha; int ldc;
    float* xs; unsigned* pcnt; const float* gain;
    __device__ __forceinline__ void fused(f32x4 (&acc)[2][2][4][2], const Unit& u, int wr, int wc, int fr, int fq, PG8_LAS unsigned char* lds, int wid, int lane) const {
        add_resid(acc, 0.5f * ALPHA2, lds, wr, wc, fr, fq);
        if constexpr (FUSENORM) {
            const int row0f = u.pm * BM + wr * 64 + fr, col0f = u.pn * BM + wc * 32 + 8 * fq;
#pragma unroll
            for (int ai = 0; ai < 2; ++ai)
#pragma unroll
                for (int m = 0; m < 4; ++m) { const int row = row0f + ai * HALF + m * 16; float q = 0.f;
#pragma unroll
                    for (int bj = 0; bj < 2; ++bj) { const f32x4 o0 = acc[ai][bj][m][0], o1 = acc[ai][bj][m][1];
                        q += ((o0[0] * o0[0] + o0[1] * o0[1]) + (o0[2] * o0[2] + o0[3] * o0[3])) + ((o1[0] * o1[0] + o1[1] * o1[1]) + (o1[2] * o1[2] + o1[3] * o1[3])); }
                    q += __shfl_xor(q, 16); q += __shfl_xor(q, 32);
                    if (fq == 0) __hip_atomic_store(xs + (size_t)row * 16 + u.pn * 4 + wc, q, __ATOMIC_RELAXED, __HIP_MEMORY_SCOPE_AGENT); }
            asm volatile("s_waitcnt vmcnt(0)" ::: "memory");
            unsigned* cnt = pcnt + 64 * u.pm;
            if (fr == 0 && fq == 0) (void)__hip_atomic_fetch_add(cnt, 1u, __ATOMIC_RELAXED, __HIP_MEMORY_SCOPE_AGENT);
            if (wr == 0 && wc == 0) { unsigned sp = 0;
                while ((unsigned)__builtin_amdgcn_readfirstlane(__hip_atomic_load(cnt, __ATOMIC_RELAXED, __HIP_MEMORY_SCOPE_AGENT)) < 32u) { __builtin_amdgcn_s_sleep(2); if (++sp > (1u << 20)) break; }
                __builtin_amdgcn_fence(__ATOMIC_ACQUIRE, "agent");
                asm volatile("s_waitcnt vmcnt(0)" ::: "memory"); }
            asm volatile("s_waitcnt lgkmcnt(0)" ::: "memory"); __builtin_amdgcn_s_barrier(); asm volatile("" ::: "memory");
            f32x4 gv[2][2];
#pragma unroll
            for (int bj = 0; bj < 2; ++bj) { gv[bj][0] = *(const f32x4*)(gain + col0f + bj * HALF); gv[bj][1] = *(const f32x4*)(gain + col0f + bj * HALF + 4); }
#pragma unroll
            for (int ai = 0; ai < 2; ++ai)
#pragma unroll
                for (int m = 0; m < 4; ++m) { const int row = row0f + ai * HALF + m * 16; const size_t off = (size_t)row * ldc + col0f;
                    const float* xp = xs + (size_t)row * 16 + 4 * fq;
                    float s = (__hip_atomic_load(xp, __ATOMIC_RELAXED, __HIP_MEMORY_SCOPE_AGENT) + __hip_atomic_load(xp + 1, __ATOMIC_RELAXED, __HIP_MEMORY_SCOPE_AGENT))
                            + (__hip_atomic_load(xp + 2, __ATOMIC_RELAXED, __HIP_MEMORY_SCOPE_AGENT) + __hip_atomic_load(xp + 3, __ATOMIC_RELAXED, __HIP_MEMORY_SCOPE_AGENT));
                    s += __shfl_xor(s, 16); s += __shfl_xor(s, 32);
                    const float rs = __builtin_amdgcn_rsqf(s * (1.0f / 1024.0f) + RMS_EPS);
#pragma unroll
                    for (int bj = 0; bj < 2; ++bj) { *(f32x4*)(out + off + bj * HALF) = acc[ai][bj][m][0] * rs * gv[bj][0]; *(f32x4*)(out + off + bj * HALF + 4) = acc[ai][bj][m][1] * rs * gv[bj][1]; } }
            return;
        }
        const int row0 = u.pm * BM + wr * 64 + fr, col0 = u.pn * BM + wc * 32 + 8 * fq;
#pragma unroll
        for (int ai = 0; ai < 2; ++ai)
#pragma unroll
            for (int m = 0; m < 4; ++m) { const int row = row0 + ai * HALF + m * 16; const size_t off = (size_t)row * ldc + col0; float q = 0.f;
#pragma unroll
                for (int bj = 0; bj < 2; ++bj) { const f32x4 o0 = acc[ai][bj][m][0], o1 = acc[ai][bj][m][1];
                    if (OUTF32) { *(f32x4*)(out + off + bj * HALF) = o0; *(f32x4*)(out + off + bj * HALF + 4) = o1; }
                    q += ((o0[0] * o0[0] + o0[1] * o0[1]) + (o0[2] * o0[2] + o0[3] * o0[3])) + ((o1[0] * o1[0] + o1[1] * o1[1]) + (o1[2] * o1[2] + o1[3] * o1[3]));
                    if (OUTBF) { u32x4 w; w.x = cvt_pk_bf16(o0[0], o0[1]); w.y = cvt_pk_bf16(o0[2], o0[3]); w.z = cvt_pk_bf16(o1[0], o1[1]); w.w = cvt_pk_bf16(o1[2], o1[3]); *(u32x4*)(xb + off + bj * HALF) = w; } }
                q += __shfl_xor(q, 16); q += __shfl_xor(q, 32);
                if (fq == 0) ss[(size_t)row * 16 + u.pn * 4 + wc] = q; }
    }
};
struct EpiResidG {
    static constexpr bool PERM = true, AFTER_DRAIN = true, INIT = false, LDSBASE = true;
    __device__ __forceinline__ const char* base_ptr() const { return (const char*)xb; }
    bf16_t* xb; float* ss; float alpha; int ldc; const bf16_t* wgh; const bf16_t* wgl; float* gp; int mrows;
    __device__ __forceinline__ void fused(f32x4 (&acc)[2][2][4][2], const Unit& u, int wr, int wc, int fr, int fq, PG8_LAS unsigned char* lds, int wid, int lane) const {
        const int row0 = u.pm * BM + wr * 64 + fr, col0 = u.pn * BM + wc * 32 + 8 * fq;
        add_resid(acc, 0.5f, lds, wr, wc, fr, fq);
        asm volatile("s_waitcnt lgkmcnt(0)" ::: "memory"); __builtin_amdgcn_s_barrier(); asm volatile("" ::: "memory");
        bf16x8 bh[2], bl[2];
#pragma unroll
        for (int bj = 0; bj < 2; ++bj) { bh[bj] = *(const bf16x8*)(wgh + (size_t)fr * ldc + col0 + bj * HALF); bl[bj] = *(const bf16x8*)(wgl + (size_t)fr * ldc + col0 + bj * HALF); }
        f32x4 gacc[8];
#pragma unroll
        for (int ai = 0; ai < 2; ++ai)
#pragma unroll
            for (int m = 0; m < 4; ++m) { const int row = row0 + ai * HALF + m * 16; const size_t off = (size_t)row * ldc + col0; float q = 0.f; f32x4 ga = (f32x4){0.f, 0.f, 0.f, 0.f};
#pragma unroll
                for (int bj = 0; bj < 2; ++bj) { const f32x4 o0 = acc[ai][bj][m][0], o1 = acc[ai][bj][m][1];
                    q += ((o0[0] * o0[0] + o0[1] * o0[1]) + (o0[2] * o0[2] + o0[3] * o0[3])) + ((o1[0] * o1[0] + o1[1] * o1[1]) + (o1[2] * o1[2] + o1[3] * o1[3]));
                    u32x4 w; w.x = cvt_pk_bf16(o0[0], o0[1]); w.y = cvt_pk_bf16(o0[2], o0[3]); w.z = cvt_pk_bf16(o1[0], o1[1]); w.w = cvt_pk_bf16(o1[2], o1[3]); *(u32x4*)(xb + off + bj * HALF) = w;
                    const bf16x8 af = __builtin_bit_cast(bf16x8, w);
                    ga = __builtin_amdgcn_mfma_f32_16x16x32_bf16(af, bh[bj], ga, 0, 0, 0); ga = __builtin_amdgcn_mfma_f32_16x16x32_bf16(af, bl[bj], ga, 0, 0, 0); }
                q += __shfl_xor(q, 16); q += __shfl_xor(q, 32);
                if (fq == 0) ss[(size_t)row * 16 + u.pn * 4 + wc] = q;
                gacc[ai * 4 + m] = ga; }
        PG8_LAS float* LP = (PG8_LAS float*)lds;
#pragma unroll
        for (int ai = 0; ai < 2; ++ai)
#pragma unroll
            for (int m = 0; m < 4; ++m)
#pragma unroll
                for (int r = 0; r < 4; ++r) LP[(wc * 256 + ai * HALF + wr * 64 + m * 16 + 4 * fq + r) * 16 + fr] = gacc[ai * 4 + m][r];
        asm volatile("s_waitcnt lgkmcnt(0)" ::: "memory"); __builtin_amdgcn_s_barrier(); asm volatile("" ::: "memory");
        { const int t = wid * 64 + lane, lr = t >> 1, g0 = (t & 1) * 8;
          f32x4 s0 = *(const PG8_LAS f32x4*)(LP + lr * 16 + g0), s1 = *(const PG8_LAS f32x4*)(LP + lr * 16 + g0 + 4);
#pragma unroll
          for (int w = 1; w < 4; ++w) { s0 = s0 + *(const PG8_LAS f32x4*)(LP + (w * 256 + lr) * 16 + g0); s1 = s1 + *(const PG8_LAS f32x4*)(LP + (w * 256 + lr) * 16 + g0 + 4); }
          float* dst = gp + ((size_t)u.pn * mrows + (size_t)u.pm * BM + lr) * 16 + g0; *(f32x4*)dst = s0; *(f32x4*)(dst + 4) = s1; }
    }
};
struct EpiProj {
    static constexpr bool PERM = true, AFTER_DRAIN = false, INIT = false, LDSBASE = false;
    bf16_t* P; int ldp; const float* ss; const PG8_LAS float* rt;
    __device__ __forceinline__ void operator()(const f32x4 (&acc)[2][2][4][2], const Unit& u, int wr, int wc, int fr, int fq) const {
        const int row0 = u.pm * BM + wr * 64 + fr, col0 = u.pn * BM + wc * 32 + 8 * fq;
        float rsv[8];
#pragma unroll
        for (int k = 0; k < 8; ++k) rsv[k] = rt[(row0 + (k >> 2) * HALF + (k & 3) * 16) & 255];
#pragma unroll
        for (int ai = 0; ai < 2; ++ai)
#pragma unroll
            for (int m = 0; m < 4; ++m) { const int row = row0 + ai * HALF + m * 16; const float rs = rsv[ai * 4 + m];
#pragma unroll
                for (int bj = 0; bj < 2; ++bj) { const f32x4 v0 = acc[ai][bj][m][0] * rs, v1 = acc[ai][bj][m][1] * rs;
                    u32x4 w; w.x = cvt_pk_bf16(v0[0], v0[1]); w.y = cvt_pk_bf16(v0[2], v0[3]); w.z = cvt_pk_bf16(v1[0], v1[1]); w.w = cvt_pk_bf16(v1[2], v1[3]);
                    *(u32x4*)(P + (size_t)row * ldp + col0 + bj * HALF) = w; } }
    }
};
template <class Epi, class Sched, bool ALIGN_EPI = false, bool SP2 = false>
__device__ __forceinline__ void gemm_phase(PG8_LAS unsigned char* lds, const Gemm g, const Sched& S, const Epi& E) {
    const int tid = threadIdx.x, wid = __builtin_amdgcn_readfirstlane(tid >> 6), lane = tid & 63, wr = wid >> 2, wc = wid & 3, fr = lane & 15, fq = lane >> 4;
    const int K = g.K, nt = K / BK;
    unsigned voffA[2], voffB[2];
#pragma unroll
    for (int i = 0; i < 2; ++i) { int R, C; stage_rc(tid * 16 + i * 8192, R, C); const int Rb = Epi::PERM ? ((R & ~31) + perm32(R & 31)) : R;
        voffA[i] = (unsigned)(R * K + C) * 2u; voffB[i] = (unsigned)(Rb * K + C) * 2u; }
    const size_t kstep = (size_t)(BK * 2);
    const size_t hstep = (size_t)HALF * K * 2;
    const size_t tstep = 2 * hstep;
    const unsigned ldsw = (unsigned)wid * 1024u;
    const int aoff = lds_byte(wr * 64 + fr, fq * 8), boff = lds_byte(wc * 32 + fr, fq * 8);
#define PG8_SA(b, h) (((b) * 2 + (h)) * HTB)
#define PG8_SB(b, h) ((4 + (b) * 2 + (h)) * HTB)
#define PG8_STAGE(bufoff, gbase, voff) do { _Pragma("unroll") for (int _i = 0; _i < 2; ++_i) \
        __builtin_amdgcn_global_load_lds((const unsigned*)((const char*)(gbase) + (voff)[_i]), (PG8_LAS unsigned*)(lds + (bufoff) + ldsw + _i * 8192), 16, 0, 0); } while (0)
#define PG8_STAGE2(bufoff, gbase, v0, v1) do { __builtin_amdgcn_global_load_lds((const unsigned*)((const char*)(gbase) + (v0)), (PG8_LAS unsigned*)(lds + (bufoff) + ldsw), 16, 0, 0); \
        __builtin_amdgcn_global_load_lds((const unsigned*)((const char*)(gbase) + (v1)), (PG8_LAS unsigned*)(lds + (bufoff) + ldsw + 8192), 16, 0, 0); } while (0)
#define PG8_LDA(dst, b, h) do { _Pragma("unroll") for (int m = 0; m < 4; ++m) _Pragma("unroll") for (int k = 0; k < 2; ++k) dst[m][k] = *(const PG8_LAS bf16x8*)(lds + PG8_SA(b, h) + aoff + m * 2048 + k * 1024); } while (0)
#define PG8_LDB(dst, b, h) do { _Pragma("unroll") for (int n = 0; n < 2; ++n) _Pragma("unroll") for (int k = 0; k < 2; ++k) dst[n][k] = *(const PG8_LAS bf16x8*)(lds + PG8_SB(b, h) + boff + n * 2048 + k * 1024); } while (0)
#define PG8_MMA(ai, bj, At, Bt) do { __builtin_amdgcn_s_setprio(3); _Pragma("unroll") for (int m = 0; m < 4; ++m) _Pragma("unroll") for (int n = 0; n < 2; ++n) _Pragma("unroll") for (int k = 0; k < 2; ++k) \
        acc[ai][bj][m][n] = __builtin_amdgcn_mfma_f32_16x16x32_bf16(Bt[n][k], At[m][k], acc[ai][bj][m][n], 0, 0, 0); __builtin_amdgcn_s_setprio(0); } while (0)
#define PG8_WAIT_V(n) asm volatile("s_waitcnt vmcnt(" #n ")" ::: "memory")
#define PG8_WAIT_L(n) asm volatile("s_waitcnt lgkmcnt(" #n ")" ::: "memory")
#define PG8_BAR __builtin_amdgcn_s_barrier()
#define PG8_SCHED __builtin_amdgcn_sched_barrier(0)
    int ldx = 0; const char* xb0 = nullptr; if constexpr (Epi::LDSBASE) { ldx = E.ldc; xb0 = E.base_ptr(); }
    Unit cur, nxt; int ui = 0;
    if (!S.next(0, cur)) return;
    f32x4 acc[2][2][4][2];
    if constexpr (Epi::INIT) E.init(acc, cur, wr, wc, fr, fq);
    else {
#pragma unroll
    for (int a = 0; a < 2; ++a)
#pragma unroll
        for (int b = 0; b < 2; ++b)
#pragma unroll
            for (int m = 0; m < 4; ++m)
#pragma unroll
                for (int n = 0; n < 2; ++n) acc[a][b][m][n] = (f32x4){0.f, 0.f, 0.f, 0.f};
    }
    bf16x8 At[4][2], B0[2][2], B1[2][2];
    const char* cA = (const char*)g.A + (size_t)cur.pm * tstep; const char* cB = (const char*)g.Bt + (size_t)cur.pn * tstep;
    S.a_ready(cur);
    if constexpr (SP2) {
        PG8_STAGE(PG8_SB(0, 0), cB, voffB); PG8_STAGE(PG8_SB(0, 1), cB + hstep, voffB); PG8_STAGE(PG8_SA(0, 0), cA, voffA); PG8_STAGE(PG8_SA(0, 1), cA + hstep, voffA);
        if (wr == 1) PG8_BAR;
        PG8_WAIT_V(2); PG8_BAR;
        PG8_STAGE(PG8_SB(1, 0), cB + kstep, voffB); PG8_STAGE(PG8_SB(1, 1), cB + hstep + kstep, voffB);
        PG8_WAIT_V(6); PG8_BAR;
    } else {
        PG8_STAGE(PG8_SB(0, 0), cB, voffB); PG8_STAGE(PG8_SA(0, 0), cA, voffA); PG8_STAGE(PG8_SB(0, 1), cB + hstep, voffB); PG8_STAGE(PG8_SA(0, 1), cA + hstep, voffA);
        if (wr == 1) PG8_BAR;
        PG8_WAIT_V(4); PG8_BAR;
        PG8_STAGE(PG8_SB(1, 0), cB + kstep, voffB); PG8_STAGE(PG8_SA(1, 0), cA + kstep, voffA); PG8_STAGE(PG8_SB(1, 1), cB + hstep + kstep, voffB);
        PG8_WAIT_V(6); PG8_BAR;
    }
    for (;;) {
        const bool has_next = S.next(ui + 1, nxt);
        const char* nA = has_next ? (const char*)g.A + (size_t)nxt.pm * tstep : cA; const char* nB = has_next ? (const char*)g.Bt + (size_t)nxt.pn * tstep : cB;
        for (int t = 0; t < nt; t += 2) {
            const bool last = (t == nt - 2);
            const char* a1 = cA + (size_t)(t + 1) * kstep;
            const char* a2 = last ? nA : cA + (size_t)(t + 2) * kstep; const char* b2 = last ? nB : cB + (size_t)(t + 2) * kstep;
            const char* a3 = a2 + kstep; const char* b3 = b2 + kstep;
            if (last && has_next) S.a_ready(nxt);
            const bool lb = Epi::LDSBASE && last && !has_next;
            unsigned vX0 = 0, vX1 = 0; const char* xt = cA; size_t rh = 0;
            if constexpr (Epi::LDSBASE) { if (lb) { int R, C; stage_rc(tid * 16, R, C); vX0 = (unsigned)(R * ldx + C) * 2u; stage_rc(tid * 16 + 8192, R, C); vX1 = (unsigned)(R * ldx + C) * 2u;
                xt = xb0 + ((size_t)cur.pm * BM * ldx + (size_t)cur.pn * BM) * 2; rh = (size_t)HALF * ldx * 2; } }
            if constexpr (SP2) {
            PG8_LDB(B0, 0, 0); PG8_LDB(B1, 0, 1); PG8_SCHED; PG8_LDA(At, 0, 0); PG8_STAGE(PG8_SA(1, 0), a1, voffA); PG8_STAGE(PG8_SA(1, 1), a1 + hstep, voffA);
            PG8_WAIT_V(8); PG8_WAIT_L(0); PG8_BAR; PG8_MMA(0, 0, At, B0); PG8_MMA(0, 1, At, B1); PG8_BAR; PG8_SCHED;
            PG8_LDA(At, 0, 1);
            if (lb) { PG8_STAGE2(PG8_SB(0, 0), xt, vX0, vX1); PG8_STAGE2(PG8_SB(0, 1), xt + 128, vX0, vX1); } else { PG8_STAGE(PG8_SB(0, 0), b2, voffB); PG8_STAGE(PG8_SB(0, 1), b2 + hstep, voffB); }
            PG8_WAIT_V(6); PG8_WAIT_L(0); PG8_BAR; PG8_MMA(1, 0, At, B0); PG8_MMA(1, 1, At, B1); PG8_BAR; PG8_SCHED;
            PG8_LDB(B0, 1, 0); PG8_LDB(B1, 1, 1); PG8_SCHED; PG8_LDA(At, 1, 0);
            if (lb) { PG8_STAGE2(PG8_SA(0, 0), xt + 256, vX0, vX1); PG8_STAGE2(PG8_SA(0, 1), xt + 384, vX0, vX1); PG8_STAGE2(8 * HTB, xt + rh + 384, vX0, vX1); PG8_WAIT_V(10); }
            else { PG8_STAGE(PG8_SA(0, 0), a2, voffA); PG8_STAGE(PG8_SA(0, 1), a2 + hstep, voffA); PG8_WAIT_V(8); }
            PG8_WAIT_L(0); PG8_BAR; PG8_MMA(0, 0, At, B0); PG8_MMA(0, 1, At, B1); PG8_BAR; PG8_SCHED;
            PG8_LDA(At, 1, 1);
            if (lb) { PG8_STAGE2(PG8_SB(1, 0), xt + rh, vX0, vX1); PG8_STAGE2(PG8_SB(1, 1), xt + rh + 128, vX0, vX1); PG8_STAGE2(PG8_SA(1, 0), xt + rh + 256, vX0, vX1); }
            else { PG8_STAGE(PG8_SB(1, 0), b3, voffB); PG8_STAGE(PG8_SB(1, 1), b3 + hstep, voffB); PG8_WAIT_V(6); }
            PG8_WAIT_L(0); PG8_BAR; PG8_MMA(1, 0, At, B0); PG8_MMA(1, 1, At, B1); PG8_BAR; PG8_SCHED;
            } else {
            PG8_LDB(B0, 0, 0); PG8_SCHED; PG8_LDA(At, 0, 0); PG8_STAGE(PG8_SA(1, 1), a1 + hstep, voffA);
            PG8_WAIT_L(8); PG8_BAR; PG8_WAIT_L(0); PG8_MMA(0, 0, At, B0); PG8_BAR; PG8_SCHED;
            PG8_LDB(B1, 0, 1); PG8_STAGE(PG8_SB(0, 0), b2, voffB);
            PG8_BAR; PG8_WAIT_L(0); PG8_MMA(0, 1, At, B1); PG8_BAR;
            PG8_LDA(At, 0, 1); PG8_STAGE(PG8_SA(0, 0), a2, voffA);
            PG8_BAR; PG8_WAIT_L(0); PG8_MMA(1, 0, At, B0); PG8_BAR; PG8_SCHED;
            PG8_STAGE(PG8_SB(0, 1), b2 + hstep, voffB);
            PG8_WAIT_V(6); PG8_BAR; PG8_MMA(1, 1, At, B1); PG8_BAR;
            PG8_LDB(B0, 1, 0); PG8_SCHED; PG8_LDA(At, 1, 0); PG8_STAGE(PG8_SA(0, 1), a2 + hstep, voffA);
            PG8_WAIT_L(8); PG8_BAR; PG8_WAIT_L(0); PG8_MMA(0, 0, At, B0); PG8_BAR; PG8_SCHED;
            PG8_LDB(B1, 1, 1); PG8_STAGE(PG8_SB(1, 0), b3, voffB);
            PG8_BAR; PG8_WAIT_L(0); PG8_MMA(0, 1, At, B1); PG8_BAR;
            PG8_LDA(At, 1, 1); PG8_STAGE(PG8_SA(1, 0), a3, voffA);
            PG8_BAR; PG8_WAIT_L(0); PG8_MMA(1, 0, At, B0); PG8_BAR; PG8_SCHED;
            PG8_STAGE(PG8_SB(1, 1), b3 + hstep, voffB);
            PG8_WAIT_V(6); PG8_BAR; PG8_MMA(1, 1, At, B1); PG8_BAR;
            }
        }
        if constexpr (ALIGN_EPI) { if (wr == 0) PG8_BAR; }
        if constexpr (!Epi::AFTER_DRAIN) { E(acc, cur, wr, wc, fr, fq); S.done(cur); }
        if (!has_next) break;
        if constexpr (Epi::INIT) E.init(acc, nxt, wr, wc, fr, fq);
        else {
#pragma unroll
        for (int a = 0; a < 2; ++a)
#pragma unroll
            for (int b = 0; b < 2; ++b)
#pragma unroll
                for (int m = 0; m < 4; ++m)
#pragma unroll
                    for (int n = 0; n < 2; ++n) acc[a][b][m][n] = (f32x4){0.f, 0.f, 0.f, 0.f};
        }
        cur = nxt; cA = nA; cB = nB; ++ui;
        if constexpr (ALIGN_EPI) { if (wr == 1) PG8_BAR; }
    }
    PG8_WAIT_V(0);
    if constexpr (!ALIGN_EPI) { if (wr == 0) PG8_BAR; }
    PG8_BAR;
    if constexpr (Epi::AFTER_DRAIN) { E.fused(acc, cur, wr, wc, fr, fq, lds, wid, lane); S.done(cur); }
#undef PG8_SA
#undef PG8_SB
#undef PG8_STAGE
#undef PG8_STAGE2
#undef PG8_LDA
#undef PG8_LDB
#undef PG8_MMA
#undef PG8_WAIT_V
#undef PG8_WAIT_L
#undef PG8_BAR
#undef PG8_SCHED
}
}
#define GAS __attribute__((address_space(1)))
#define LAS __attribute__((address_space(3)))
typedef unsigned short bf16;
typedef unsigned v4u __attribute__((ext_vector_type(4)));
typedef float f32x4 __attribute__((ext_vector_type(4)));
typedef short bf16x8 __attribute__((ext_vector_type(8)));
typedef GAS unsigned gu32;
typedef GAS unsigned long long gu64;
#define RLX_AGENT __ATOMIC_RELAXED, __HIP_MEMORY_SCOPE_AGENT
#define LDS_WAIT() asm volatile("s_waitcnt lgkmcnt(0)" ::: "memory")
#define VM_WAIT() asm volatile("s_waitcnt vmcnt(0)" ::: "memory")
__device__ __forceinline__ unsigned long long rt() { return __builtin_amdgcn_s_memrealtime(); }
__device__ __forceinline__ unsigned f2bf(float f) { unsigned u = __builtin_bit_cast(unsigned, f); return (u + 0x7fffu + ((u >> 16) & 1u)) >> 16; }
__device__ __forceinline__ unsigned pk2(float lo, float hi) { return f2bf(lo) | (f2bf(hi) << 16); }
#define XB_TMO      128
#define XB_XCNT(j)  (256  + 64 * (j))
#define XB_XSUB(j)  (1280 + 64 * (j))
#define XB_XGEN(j)  (2304 + 64 * (j))
#define XB_TOP      3328
#define XB_TOPGEN   3392
#define XCD_BAR_WORDS 3456
#define XB_SPIN_CAP (1u << 18)

__device__ __forceinline__ unsigned xb_ld(unsigned* p)              { return __hip_atomic_load(p, __ATOMIC_RELAXED, __HIP_MEMORY_SCOPE_AGENT); }
__device__ __forceinline__ unsigned xb_add(unsigned* p, unsigned v) { return __hip_atomic_fetch_add(p, v, __ATOMIC_RELAXED, __HIP_MEMORY_SCOPE_AGENT); }
__device__ __forceinline__ unsigned xb_xcc_id() { return (unsigned)__builtin_amdgcn_s_getreg((3 << 11) | 20) & 0xFu; }
#define XB_SPIN(cond, bar) do { unsigned _sp = 0; while (cond) { __builtin_amdgcn_s_sleep(1); \
    if ((++_sp & 255u) == 0u) { if (xb_ld(&(bar)[XB_TMO])) break; if (_sp > XB_SPIN_CAP) { atomicAdd(&(bar)[XB_TMO], 1u); break; } } } } while (0)

struct XcdBarrier {
    unsigned* bar; unsigned x;
    volatile LAS unsigned* st;
};

__device__ __forceinline__ XcdBarrier xcd_barrier_post(unsigned* bar, volatile LAS unsigned* st) {
    XcdBarrier b; b.bar = bar; b.x = xb_xcc_id(); b.st = st;
    if (threadIdx.x == 0) (void)xb_add(&bar[XB_XCNT(b.x)], 1u);
    return b;
}
__device__ __forceinline__ void xcd_barrier_complete(unsigned* bar, unsigned x, unsigned& nloc, unsigned& nx) {
    const unsigned G = gridDim.x * gridDim.y * gridDim.z;
    unsigned sum, cnt, mine, sp = 0u;
    for (;;) {
        sum = 0u; cnt = 0u; mine = 0u;
#pragma unroll
        for (unsigned j = 0; j < 16; ++j) { const unsigned c = xb_ld(&bar[XB_XCNT(j)]); sum += c; cnt += (c > 0u) ? 1u : 0u; mine = (j == x) ? c : mine; }
        if (sum == G) break;
        __builtin_amdgcn_s_sleep(1);
        if ((++sp & 255u) == 0u) { if (xb_ld(&bar[XB_TMO])) break; if (sp > XB_SPIN_CAP) { atomicAdd(&bar[XB_TMO], 1u); break; } }
    }
    nloc = mine > 0u ? mine : 1u; nx = cnt > 0u ? cnt : 1u;
}

__device__ __forceinline__ void xcd_barrier(const XcdBarrier& b) {
    asm volatile("s_waitcnt vmcnt(0)" ::: "memory");
    __syncthreads();
    if (threadIdx.x == 0) {
        unsigned* bar = b.bar;
        __builtin_amdgcn_s_waitcnt(0);
        unsigned nloc = b.st[0], nx = b.st[1];
        if (nloc == 0u) { xcd_barrier_complete(bar, b.x, nloc, nx); b.st[0] = nloc; b.st[1] = nx; }
        const unsigned old = xb_add(&bar[XB_XSUB(b.x)], 1u);
        const unsigned gen = old / nloc;
        if (old + 1u == (gen + 1u) * nloc) {
            __builtin_amdgcn_fence(__ATOMIC_RELEASE, "agent");
            asm volatile("s_waitcnt vmcnt(0)" ::: "memory");
            const unsigned og = xb_add(&bar[XB_TOP], 1u);
            const unsigned tg = og / nx;
            if (og + 1u == (tg + 1u) * nx) xb_add(&bar[XB_TOPGEN], 1u);
            else XB_SPIN(xb_ld(&bar[XB_TOPGEN]) == tg, bar);
            __builtin_amdgcn_fence(__ATOMIC_ACQUIRE, "agent");
            xb_add(&bar[XB_XGEN(b.x)], 1u);
            asm volatile("s_waitcnt vmcnt(0)" ::: "memory");
        } else {
            XB_SPIN(xb_ld(&bar[XB_XGEN(b.x)]) == gen, bar);
            __builtin_amdgcn_fence(__ATOMIC_ACQUIRE, "agent");
            asm volatile("s_waitcnt vmcnt(0)" ::: "memory");
        }
    }
    __syncthreads();
}

constexpr int NWAVES = 8;
constexpr int BATCH = 2, T = 8192, D = 1024, M = BATCH * T, FF = 2816, NFF2 = 2 * FF;
constexpr int MLH = 4, MLD = 128, MLW = 512, NAH = 8, NAD = 64, NG = 16, DIN = 3088, NPROJ = 3072;
constexpr int GW = 64, GROWS = T / GW;
constexpr int PC_C = 0, PC_V = 512, PC_O = 1024, PC_QN = 1536, PC_KN = 2048, PC_VN = 2560;
constexpr float EPS = 1e-6f;

constexpr size_t MiB = 1u << 20;
constexpr size_t WS_CTL = 0, CTL_ZERO_BYTES = 1 * MiB;
constexpr size_t WS_W1T = 2 * MiB;
constexpr size_t WS_W1DT = 13 * MiB;
constexpr size_t WS_WINT = 19 * MiB;
constexpr size_t WS_WOUTT = 25 * MiB;
constexpr size_t WS_W2T = 27 * MiB;
constexpr size_t WS_W2DT = 38 * MiB;
constexpr size_t WS_WQT = 44 * MiB;
constexpr size_t WS_WG = 45 * MiB;
constexpr size_t WS_SS = 46 * MiB;
constexpr size_t WS_GATES = 246 * MiB;
constexpr size_t WS_XS = 49 * MiB;
constexpr size_t WS_XB = 50 * MiB;
constexpr size_t WS_HP = 82 * MiB;
constexpr size_t WS_Y = 178 * MiB;
constexpr size_t WS_CHS = 48 * MiB;
constexpr size_t WS_M0 = 48 * MiB + 65536;
constexpr size_t WS_CL = 210 * MiB;
constexpr size_t WS_END = 256 * MiB;
constexpr int CW_TMO = 0, CW_CODE = 1, CW_BAR = 4096, CW_PAN = 8192;

constexpr int RING_OFF = 0, RING_BYTES = 131072;
constexpr int LDS_BYTES = 163840;
constexpr int LDSCTL_OFF = LDS_BYTES - 512, MISC_OFF = LDSCTL_OFF + 320;

__device__ __forceinline__ float wave_sum(float v) {
#pragma unroll
    for (int o = 1; o < 64; o <<= 1) v += __shfl_xor(v, o);
    return v;
}
__device__ __forceinline__ float wave_max(float v) {
#pragma unroll
    for (int o = 1; o < 64; o <<= 1) v = fmaxf(v, __shfl_xor(v, o));
    return v;
}
__device__ __forceinline__ float bf2f(bf16 v) { return __builtin_bit_cast(float, (unsigned)v << 16); }

__device__ __forceinline__ void transpose_item(const float* W, int ldw, int k0, int nsrc0, const float* gain, bf16* WT, int K, int dstrow0, LAS float* scr, int lane, float scale = 1.0f) {
    float tv[32];
#pragma unroll
    for (int i = 0; i < 32; ++i) tv[i] = __builtin_nontemporal_load(W + (size_t)(k0 + 2 * i + (lane >> 5)) * ldw + nsrc0 + (lane & 31));
#pragma unroll
    for (int i = 0; i < 32; ++i) { const int kk = 2 * i + (lane >> 5); float v = tv[i]; if (gain) v *= gain[k0 + kk]; scr[kk * 33 + (lane & 31)] = v * scale; }
    LDS_WAIT(); asm volatile("" ::: "memory");
    const int c = lane & 7;
#pragma unroll
    for (int j = 0; j < 4; ++j) { const int n = (lane >> 3) + 8 * j; const LAS float* s = scr + (8 * c) * 33 + n;
        v4u o; o.x = pk2(s[0 * 33], s[1 * 33]); o.y = pk2(s[2 * 33], s[3 * 33]); o.z = pk2(s[4 * 33], s[5 * 33]); o.w = pk2(s[6 * 33], s[7 * 33]);
        *(GAS v4u*)(WT + (size_t)(dstrow0 + n) * K + k0 + 8 * c) = o; }
    LDS_WAIT(); asm volatile("" ::: "memory");
}

__device__ __forceinline__ void transpose_item_wide_load(f32x4 (&tv)[16], const float* W, int ldw, int k0, int nsrc0, int lane) {
#pragma unroll
    for (int i = 0; i < 16; ++i) tv[i] = __builtin_nontemporal_load((const GAS f32x4*)(W + (size_t)(k0 + 2 * i + (lane >> 5)) * ldw + nsrc0 + 4 * (lane & 31)));
}
__device__ __forceinline__ void transpose_item_wide_finish(const f32x4 (&tv)[16], int k0, const float* gain, bf16* WT, int K, int dstrow0, LAS float* scr, int lane) {
    constexpr int PITCH = 132;
#pragma unroll
    for (int i = 0; i < 16; ++i) { const int kk = 2 * i + (lane >> 5); const float gs = gain ? gain[k0 + kk] : 1.0f; *(LAS f32x4*)(scr + kk * PITCH + 4 * (lane & 31)) = tv[i] * gs; }
    LDS_WAIT(); asm volatile("" ::: "memory");
#pragma unroll
    for (int r = 0; r < 8; ++r) { const int idx = lane + 64 * r, n = idx >> 2, c = idx & 3; const LAS float* s = scr + (8 * c) * PITCH + n;
        v4u o; o.x = pk2(s[0 * PITCH], s[1 * PITCH]); o.y = pk2(s[2 * PITCH], s[3 * PITCH]); o.z = pk2(s[4 * PITCH], s[5 * PITCH]); o.w = pk2(s[6 * PITCH], s[7 * PITCH]);
        *(GAS v4u*)(WT + (size_t)(dstrow0 + n) * K + k0 + 8 * c) = o; }
    LDS_WAIT(); asm volatile("" ::: "memory");
}
__device__ __forceinline__ void transpose_item_wide(const float* W, int ldw, int k0, int nsrc0, const float* gain, bf16* WT, int K, int dstrow0, LAS float* scr, int lane) {
    f32x4 tv[16]; transpose_item_wide_load(tv, W, ldw, k0, nsrc0, lane); transpose_item_wide_finish(tv, k0, gain, WT, K, dstrow0, scr, lane);
}
struct Ptrs {
    const float *x, *g1, *w1g, *w1u, *w1d, *gm, *win, *bg, *cw, *cb, *wq, *wk, *gn, *gq, *gk, *rpb, *wout, *g2, *w2g, *w2u, *w2d, *gf;
    float* out;
    bf16 *W1T, *W1DT, *WINT, *WOUTT, *W2T, *W2DT, *XB, *QB, *KB, *H, *PROJ, *Y;
    bf16 *WGH, *WGL, *WQT, *WKT; float *SS, *GATES;
};

__device__ __forceinline__ void p0_deferred(const Ptrs& P, LAS unsigned char* lds, int lo, int hi, int dw, int NDW, int lane, int wave) {
    LAS float* scr = (LAS float*)(lds + RING_OFF + wave * 16384);
    constexpr int I_GU = 16 * 88, I_DN = 44 * 32, I_IN = 16 * 96, I_OUT = 16 * 32;
    constexpr int NITEMS = 2 * I_DN + I_IN + I_OUT + 2 * I_GU;
    (void)NITEMS;
    for (int it = lo + dw; it < hi; it += NDW) {
        int r = it;
        if (r < I_DN) { const int kb = r / 32, nb = r % 32; transpose_item(P.w1d, D, 64 * kb, 32 * nb, nullptr, P.W1DT, FF, 32 * nb, scr, lane); continue; }
        r -= I_DN;
        if (r < I_IN) { const int kb = r / 96, nb = r % 96, nd = 32 * nb, ns = nd < 1536 ? nd : nd + 16; transpose_item(P.win, DIN, 64 * kb, ns, P.gm, P.WINT, D, nd, scr, lane); continue; }
        r -= I_IN;
        if (r < I_OUT) { const int kb = r / 32, nb = r % 32; transpose_item(P.wout, D, 64 * kb, 32 * nb, nullptr, P.WOUTT, D, 32 * nb, scr, lane); continue; }
        r -= I_OUT;
        if (r < 2 * I_GU) { const bool up = r >= I_GU; if (up) r -= I_GU; const int kb = r / 88, nb = r % 88, n0 = 32 * nb, dst = 256 * (n0 >> 7) + (n0 & 127) + (up ? 128 : 0);
            transpose_item(up ? P.w2u : P.w2g, FF, 64 * kb, n0, P.g2, P.W2T, D, dst, scr, lane); continue; }
        r -= 2 * I_GU;
        { const int kb = r / 32, nb = r % 32; transpose_item(P.w2d, D, 64 * kb, 32 * nb, nullptr, P.W2DT, FF, 32 * nb, scr, lane); }
    }
}
__device__ __forceinline__ void p0_prologue(const Ptrs& P, LAS unsigned char* lds, int gw, int NGW, int lane, int wave, int gtid, int NGT) {
    LAS float* scr = (LAS float*)(lds + RING_OFF + wave * 17408);
    f32x4 v[8][4];
#define P0_ROWS_LOAD(m0_) do { _Pragma("unroll") for (int r = 0; r < 8; ++r) { const int mm = (NGW == 2048) ? 8 * (m0_) + r : (m0_) + r * NGW;     const GAS f32x4* xr = (const GAS f32x4*)(P.x + (size_t)(mm < M ? mm : (m0_)) * D) + lane; \
        _Pragma("unroll") for (int j = 0; j < 4; ++j) v[r][j] = __builtin_nontemporal_load(xr + 64 * j); } } while (0)
    constexpr int I_GUW = 32 * 22;
    const int it0 = wave * (NGW / NWAVES) + gw / NWAVES;
    { f32x4 tv[16]; int r = it0; const bool has = r < 2 * I_GUW; const bool up = r >= I_GUW; if (up) r -= I_GUW; const int kb = r / 22, nb = r % 22;
      if (has) transpose_item_wide_load(tv, up ? P.w1u : P.w1g, FF, 32 * kb, 128 * nb, lane);
      P0_ROWS_LOAD(gw);
      if (has) transpose_item_wide_finish(tv, 32 * kb, P.g1, P.W1T, D, 256 * nb + (up ? 128 : 0), scr, lane); }
    for (int it = it0 + NGW; it < 2 * I_GUW; it += NGW) { int r = it; const bool up = r >= I_GUW; if (up) r -= I_GUW; const int kb = r / 22, nb = r % 22;
        transpose_item_wide(up ? P.w1u : P.w1g, FF, 32 * kb, 128 * nb, P.g1, P.W1T, D, 256 * nb + (up ? 128 : 0), scr, lane); }
    if (wave == NWAVES - 1) for (int it = gw / NWAVES; it < 64; it += NGW / NWAVES) { const int isk = it >> 5,     hh = (it >> 3) & 3, kb = (it >> 2) & 1, nb = it & 3;
        transpose_item((isk ? P.wk : P.wq) + (size_t)hh * MLD * MLD, MLD, 64 * kb, 32 * nb, nullptr, (isk ? P.WKT : P.WQT) + (size_t)hh * MLD * MLD, MLD, 32 * nb, scr, lane, isk ? 0.08838834764831845f : 1.0f); }
    if (wave == NWAVES - 2) for (int i = (gw / NWAVES) * 64 + lane; i < NG * D; i += (NGW / NWAVES) * 64) { const int j = i >> 10, k = i & 1023;     const float w = P.gm[k] * P.win[(size_t)k * DIN + 1536 + j]; const unsigned h = f2bf(w);
        P.WGH[i] = (bf16)h; P.WGL[i] = (bf16)f2bf(w - __builtin_bit_cast(float, h << 16)); }
    for (int m0_ = gw; m0_ < M; m0_ += 8 * NGW) {
        if (m0_ != gw) P0_ROWS_LOAD(m0_);
        float s[8];
#pragma unroll
        for (int r = 0; r < 8; ++r) { float q = 0.f;
#pragma unroll
            for (int j = 0; j < 4; ++j) q += (v[r][j].x * v[r][j].x + v[r][j].y * v[r][j].y) + (v[r][j].z * v[r][j].z + v[r][j].w * v[r][j].w);
            s[r] = q; }
#pragma unroll
        for (int o = 1; o < 64; o <<= 1) {
#pragma unroll
            for (int r = 0; r < 8; ++r) s[r] += __shfl_xor(s[r], o); }
#pragma unroll
        for (int r = 0; r < 8; ++r) { const int mm = (NGW == 2048) ? 8 * m0_ + r : m0_ + r * NGW; if (mm < M) {
            GAS unsigned long long* o8 = (GAS unsigned long long*)(P.XB + (size_t)mm * D) + lane;
#pragma unroll
            for (int j = 0; j < 4; ++j) o8[64 * j] = (unsigned long long)pk2(v[r][j].x, v[r][j].y) | ((unsigned long long)pk2(v[r][j].z, v[r][j].w) << 32);
            if (lane < 16) P.SS[(size_t)mm * 16 + lane] = lane == 0 ? s[r] : 0.f; } }
    }
#undef P0_ROWS_LOAD
}

__device__ __forceinline__ float logsigmoidf(float x) { return fminf(x, 0.f) - log1pf(__expf(-fabsf(x))); }


constexpr int MLC = 128, NCH = T / MLC, MLP = 144, MLPB = MLP * 2;
constexpr int CL_STATE_BYTES = MLP * MLD * 2;
typedef short v4i16_t __attribute__((ext_vector_type(4)));
typedef float f32x2_t __attribute__((ext_vector_type(2))); typedef __bf16 bf16x2_t __attribute__((ext_vector_type(2)));
__device__ __forceinline__ unsigned cvtpk(float lo, float hi) { f32x2_t v = {lo, hi}; bf16x2_t b = __builtin_convertvector(v, bf16x2_t); return __builtin_bit_cast(unsigned, b); }
__device__ __forceinline__ bf16x8 tr_pair(const LAS unsigned char* p0, const LAS unsigned char* p1) {
    const v4i16_t a = __builtin_amdgcn_ds_read_tr16_b64_v4i16((LAS v4i16_t*)p0), b = __builtin_amdgcn_ds_read_tr16_b64_v4i16((LAS v4i16_t*)p1);
    return (bf16x8){a[0], a[1], a[2], a[3], b[0], b[1], b[2], b[3]};
}
__device__ __forceinline__ float bflo(unsigned w) { return __builtin_bit_cast(float, w << 16); }
__device__ __forceinline__ float bfhi(unsigned w) { return __builtin_bit_cast(float, w & 0xffff0000u); }
__device__ __forceinline__ v4u scale_bf16x8(v4u v, float s) {
    v4u o; o.x = cvtpk(bflo(v.x) * s, bfhi(v.x) * s); o.y = cvtpk(bflo(v.y) * s, bfhi(v.y) * s); o.z = cvtpk(bflo(v.z) * s, bfhi(v.z) * s); o.w = cvtpk(bflo(v.w) * s, bfhi(v.w) * s); return o;
}
__device__ __forceinline__ float wave_incl_sum(float v, int lane) {
#pragma unroll
    for (int o = 1; o < 64; o <<= 1) { const float t = __shfl_up(v, o); if (lane >= o) v += t; }
    return v;
}
__device__ __forceinline__ float wave_incl_max(float v, int lane) {
#pragma unroll
    for (int o = 1; o < 64; o <<= 1) { const float t = __shfl_up(v, o); if (lane >= o) v = fmaxf(v, t); }
    return v;
}
__device__ __forceinline__ void ml_load_gates(const float* GATES, const float* SS, const float* bg, int row0, int hh, LAS float* G4, int tid) {
    if (tid < MLC) { const float* gp = GATES + (size_t)(row0 + tid) * NG + hh; const float rs = pg8::rstd_from_ss(SS, row0 + tid);
        float v[4];
#pragma unroll
        for (int k = 0; k < 4; ++k) v[k] = (gp[4 * k] + gp[(size_t)M * NG + 4 * k]) + (gp[(size_t)2 * M * NG + 4 * k] + gp[(size_t)3 * M * NG + 4 * k]);
        G4[tid] = rs * v[0] + bg[hh]; G4[MLC + tid] = logsigmoidf(rs * v[1] + bg[4 + hh]);
        G4[2 * MLC + tid] = rs * v[2] + bg[8 + hh]; G4[3 * MLC + tid] = logsigmoidf(rs * v[3] + bg[12 + hh]); }
}

__device__ __forceinline__ void mlb_unit(const Ptrs& P, bf16* CL, float* CHS, LAS unsigned char* lds, int unit, int tid, int wave, int lane, const bf16x8 (&aq)[4], const bf16x8 (&ak)[4]) {
    typedef unsigned u32x2v __attribute__((ext_vector_type(2)));
    asm volatile("" : "+v"(tid), "+v"(lane));
    const int c = unit & (NCH - 1), bh = unit / NCH, b = bh >> 2, hh = bh & 3, row0 = b * T + c * MLC;
    LAS unsigned char* KF = lds; LAS unsigned char* KW = lds + MLC * MLPB; LAS unsigned char* VP = lds + 2 * MLC * MLPB;
    LAS float* G4 = (LAS float*)(lds + 3 * MLC * MLPB); LAS float* WF = G4 + 4 * MLC; LAS float* WB = WF + MLC;
    const int i = lane & 15, g = lane >> 4, tq = i >> 2, tp = i & 3;
    const int ch8 = tid & 15, tg = tid >> 4, cbase = hh * MLD + 8 * ch8;
    v4u xin[8]; f32x4 cwv[5][2]; f32x4 cbv0, cbv1;
#pragma unroll
    for (int k = 0; k < 8; ++k) { const int tt = c * MLC + 4 * tg - 2 + k; const int tc = min(max(tt, 0), T - 1);
        xin[k] = *(const GAS v4u*)(P.PROJ + (size_t)(b * T + tc) * NPROJ + PC_C + cbase); }
#pragma unroll
    for (int jj = 0; jj < 5; ++jj) { cwv[jj][0] = *(const GAS f32x4*)(P.cw + jj * MLW + cbase); cwv[jj][1] = *(const GAS f32x4*)(P.cw + jj * MLW + cbase + 4); }
    cbv0 = *(const GAS f32x4*)(P.cb + cbase); cbv1 = *(const GAS f32x4*)(P.cb + cbase + 4);
    v4u vpre[4];
#pragma unroll
    for (int r = 0; r < 4; ++r) { const int q = tid + 512 * r, s = q >> 4, ce = q & 15; vpre[r] = *(const GAS v4u*)(P.PROJ + (size_t)(row0 + s) * NPROJ + PC_V + hh * MLD + 8 * ce); }
    ml_load_gates(P.GATES, P.SS, P.bg, row0, hh, G4, tid);
    __syncthreads();
    if (wave < 2) { const int dir = wave; const LAS float* li = G4 + 2 * dir * MLC; const LAS float* lf = li + MLC;
        const int t0 = dir ? MLC - 1 - 2 * lane : 2 * lane, t1 = dir ? t0 - 1 : t0 + 1;
        const float x0 = lf[t0], x1 = lf[t1]; const float S = wave_incl_sum(x0 + x1, lane); const float f0 = S - x1, f1 = S;
        const float a0 = li[t0] - f0, a1 = li[t1] - f1; const float amax = wave_max(fmaxf(a0, a1));
        LAS float* W = dir ? WB : WF; W[t0] = __expf(a0 - amax); W[t1] = __expf(a1 - amax);
        const float g = __shfl(S, 63);
        if (lane == 0) { float* ch = CHS + ((size_t)(dir * 8 + bh) * NCH + c) * 2; ch[0] = g; ch[1] = g + amax; } }
    { float cbv[8]; cbv[0] = cbv0[0]; cbv[1] = cbv0[1]; cbv[2] = cbv0[2]; cbv[3] = cbv0[3]; cbv[4] = cbv1[0]; cbv[5] = cbv1[1]; cbv[6] = cbv1[2]; cbv[7] = cbv1[3];
      float y[4][8];
#pragma unroll
      for (int tok = 0; tok < 4; ++tok)
#pragma unroll
          for (int e = 0; e < 8; ++e) y[tok][e] = cbv[e];
#pragma unroll
      for (int k = 0; k < 8; ++k) { const int tt = c * MLC + 4 * tg - 2 + k;
          const bool inb = tt >= 0 && tt < T; const v4u v = xin[k];
          float x[8]; x[0] = inb ? bflo(v.x) : 0.f; x[1] = inb ? bfhi(v.x) : 0.f; x[2] = inb ? bflo(v.y) : 0.f; x[3] = inb ? bfhi(v.y) : 0.f;
          x[4] = inb ? bflo(v.z) : 0.f; x[5] = inb ? bfhi(v.z) : 0.f; x[6] = inb ? bflo(v.w) : 0.f; x[7] = inb ? bfhi(v.w) : 0.f;
#pragma unroll
          for (int tok = 0; tok < 4; ++tok) { const int jj = k - tok;
              if (jj >= 0 && jj < 5) { const f32x4 w0 = cwv[jj][0], w1 = cwv[jj][1];
                  y[tok][0] += x[0] * w0[0]; y[tok][1] += x[1] * w0[1]; y[tok][2] += x[2] * w0[2]; y[tok][3] += x[3] * w0[3];
                  y[tok][4] += x[4] * w1[0]; y[tok][5] += x[5] * w1[1]; y[tok][6] += x[6] * w1[2]; y[tok][7] += x[7] * w1[3]; } } }
#pragma unroll
      for (int tok = 0; tok < 4; ++tok) { float u[8];
#pragma unroll
          for (int e = 0; e < 8; ++e) u[e] = y[tok][e] * __builtin_amdgcn_rcpf(1.0f + __builtin_amdgcn_exp2f(y[tok][e] * -1.4426950408889634f));
          v4u o; o.x = cvtpk(u[0], u[1]); o.y = cvtpk(u[2], u[3]); o.z = cvtpk(u[4], u[5]); o.w = cvtpk(u[6], u[7]);
          *(LAS v4u*)(VP + (4 * tg + tok) * MLPB + 16 * ch8) = o; } }
    __syncthreads();
    {
      const bool godd = (g & 1) != 0;
#pragma unroll
      for (int np = 0; np < 4; ++np) { u32x2v wq[2], wk[2];
#pragma unroll
        for (int h2 = 0; h2 < 2; ++h2) { const int nt = 2 * np + h2; f32x4 cq = (f32x4){0.f, 0.f, 0.f, 0.f}, ck = (f32x4){0.f, 0.f, 0.f, 0.f};
#pragma unroll
          for (int ks = 0; ks < 4; ++ks) { const bf16x8 uf = *(const LAS bf16x8*)(VP + (16 * nt + i) * MLPB + 64 * ks + 16 * g);
              cq = __builtin_amdgcn_mfma_f32_16x16x32_bf16(aq[ks], uf, cq, 0, 0, 0); ck = __builtin_amdgcn_mfma_f32_16x16x32_bf16(ak[ks], uf, ck, 0, 0, 0); }
          const int t = 16 * nt + i;
          wq[h2].x = cvtpk(cq[0], cq[1]); wq[h2].y = cvtpk(cq[2], cq[3]); wk[h2].x = cvtpk(ck[0], ck[1]); wk[h2].y = cvtpk(ck[2], ck[3]);
          const float wf = WF[t], wb = WB[t]; u32x2v w;
          w.x = cvtpk(ck[0] * wf, ck[1] * wf); w.y = cvtpk(ck[2] * wf, ck[3] * wf); *(LAS u32x2v*)(KF + t * MLPB + 32 * wave + 8 * g) = w;
          w.x = cvtpk(ck[0] * wb, ck[1] * wb); w.y = cvtpk(ck[2] * wb, ck[3] * wb); *(LAS u32x2v*)(KW + t * MLPB + 32 * wave + 8 * g) = w; }
        const unsigned rqx = __shfl_xor(godd ? wq[0].x : wq[1].x, 16), rqy = __shfl_xor(godd ? wq[0].y : wq[1].y, 16), rkx = __shfl_xor(godd ? wk[0].x : wk[1].x, 16), rky = __shfl_xor(godd ? wk[0].y : wk[1].y, 16);
        v4u oq, ok; if (godd) { oq.x = rqx; oq.y = rqy; oq.z = wq[1].x; oq.w = wq[1].y; ok.x = rkx; ok.y = rky; ok.z = wk[1].x; ok.w = wk[1].y; }
        else { oq.x = wq[0].x; oq.y = wq[0].y; oq.z = rqx; oq.w = rqy; ok.x = wk[0].x; ok.y = wk[0].y; ok.z = rkx; ok.w = rky; }
        const size_t go = (size_t)(row0 + 16 * (2 * np + (godd ? 1 : 0)) + i) * MLW + hh * MLD + 16 * wave + 4 * (g & ~1);
        *(GAS v4u*)(P.QB + go) = oq; *(GAS v4u*)(P.KB + go) = ok; } }
    __syncthreads();
#pragma unroll
    for (int r = 0; r < 4; ++r) { const int q = tid + 512 * r, s = q >> 4, ce = q & 15;
        *(LAS v4u*)(VP + s * MLPB + 16 * ce) = vpre[r]; }
    if (tid < MLC) { *(LAS v4u*)(VP + tid * MLPB + 256) = (v4u){0x00003F80u, 0u, 0u, 0u}; *(LAS v4u*)(VP + tid * MLPB + 272) = (v4u){0u, 0u, 0u, 0u}; }
    __syncthreads();
    f32x4 acc[2][9];
#pragma unroll
    for (int d = 0; d < 2; ++d)
#pragma unroll
        for (int n = 0; n < 9; ++n) acc[d][n] = (f32x4){0.f, 0.f, 0.f, 0.f};
    const int troff = (4 * g + tq) * MLPB + 8 * tp;
#pragma unroll
    for (int kk = 0; kk < 4; ++kk) {
        const int so = troff + 32 * kk * MLPB;
        const bf16x8 af = tr_pair(KF + so + 32 * wave, KF + so + 16 * MLPB + 32 * wave), ab = tr_pair(KW + so + 32 * wave, KW + so + 16 * MLPB + 32 * wave);
#pragma unroll
        for (int n = 0; n < 9; ++n) { const bf16x8 bv = tr_pair(VP + so + 32 * n, VP + so + 16 * MLPB + 32 * n);
            acc[0][n] = __builtin_amdgcn_mfma_f32_16x16x32_bf16(af, bv, acc[0][n], 0, 0, 0); acc[1][n] = __builtin_amdgcn_mfma_f32_16x16x32_bf16(ab, bv, acc[1][n], 0, 0, 0); }
    }
#pragma unroll
    for (int d = 0; d < 2; ++d) { bf16* st = CL + ((size_t)(d * 8 + bh) * NCH + c) * (MLP * MLD);
#pragma unroll
        for (int n2 = 0; n2 < 4; ++n2) { const f32x4 v0 = acc[d][2 * n2], v1 = acc[d][2 * n2 + 1]; const bool godd = (g & 1) != 0;
            const unsigned a0 = cvtpk(v0[0], v0[1]), a1 = cvtpk(v0[2], v0[3]), b0 = cvtpk(v1[0], v1[1]), b1 = cvtpk(v1[2], v1[3]);
            const unsigned rx = __shfl_xor(godd ? a0 : b0, 16), ry = __shfl_xor(godd ? a1 : b1, 16);
            v4u o; if (godd) { o.x = rx; o.y = ry; o.z = b0; o.w = b1; } else { o.x = a0; o.y = a1; o.z = rx; o.w = ry; }
            *(GAS v4u*)(st + (size_t)(16 * (2 * n2 + (godd ? 1 : 0)) + i) * MLD + 16 * wave + 4 * (g & ~1)) = o; }
        { const f32x4 v = acc[d][8]; typedef unsigned u32x2v __attribute__((ext_vector_type(2))); u32x2v w; w.x = cvtpk(v[0], v[1]); w.y = cvtpk(v[2], v[3]);
            *(GAS u32x2v*)(st + (size_t)(16 * 8 + i) * MLD + 16 * wave + 4 * g) = w; } }
    __syncthreads();
}

__device__ __forceinline__ void ml_scan(bf16* CL, const float* CHS, float* M0, LAS unsigned char* lds, int blk, int tid) {
    typedef unsigned u32x2v __attribute__((ext_vector_type(2)));
    const int combo = blk >> 3, slice = blk & 7, dir = combo >> 3;
    LAS float* AL = (LAS float*)lds; LAS float* BE = AL + NCH;
    LAS float* GS = BE + NCH; LAS float* MLS = GS + NCH;
    LAS float* OS = MLS + NCH;
    unsigned char* base = (unsigned char*)CL + (size_t)combo * NCH * CL_STATE_BYTES + (size_t)slice * 4608 + (size_t)tid * 8;
    const bool w0 = tid < 64;
    float g = 0.f, ml = 0.f;
    if (tid < NCH) { const int c = dir ? NCH - 1 - tid : tid; g = CHS[((size_t)combo * NCH + c) * 2]; ml = CHS[((size_t)combo * NCH + c) * 2 + 1]; }
    u32x2v v[16], w[16];
#define SCAN_LOAD(it0_) do { _Pragma("unroll") for (int k = 0; k < 16; ++k) { const int c = dir ? NCH - 1 - ((it0_) + k) : (it0_) + k; v[k] = __builtin_nontemporal_load((const GAS u32x2v*)(base + (size_t)c * CL_STATE_BYTES)); } \
        if (w0) { _Pragma("unroll") for (int k = 0; k < 16; ++k) { const int c = dir ? NCH - 1 - ((it0_) + k) : (it0_) + k; w[k] = *(const GAS u32x2v*)(base + 4096 + (size_t)c * CL_STATE_BYTES); } } } while (0)
    SCAN_LOAD(0);
    if (tid < NCH) { const int c = dir ? NCH - 1 - tid : tid;
        float a = g, b = ml;
#pragma unroll
        for (int off = 1; off < 64; off <<= 1) { const float ap = __shfl_up(a, off), bp = __shfl_up(b, off); if (tid >= off) { b = fmaxf(bp + a, b); a = ap + a; } }
        const float mafter = fmaxf(a, b), mprev = __shfl_up(mafter, 1), m0 = tid == 0 ? 0.f : mprev;
        const float cp = fmaxf(m0, ml - g);
        if (slice == 0) M0[combo * NCH + c] = cp;
        OS[tid] = __expf(m0 - cp);
        const float mn = fmaxf(g + m0, ml); AL[tid] = __expf(g + m0 - mn); BE[tid] = __expf(ml - mn); }
    __syncthreads();
    float s0 = 0.f, s1 = 0.f, s2 = 0.f, s3 = 0.f, t0 = 0.f, t1 = 0.f, t2 = 0.f, t3 = 0.f;
#pragma unroll 1
    for (int it0 = 0; it0 < NCH; it0 += 16) {
        if (it0) SCAN_LOAD(it0);
#pragma unroll
        for (int k = 0; k < 16; ++k) { const int c = dir ? NCH - 1 - (it0 + k) : it0 + k; const float os = OS[it0 + k]; u32x2v o; o.x = cvtpk(s0 * os, s1 * os); o.y = cvtpk(s2 * os, s3 * os);
            *(GAS u32x2v*)(base + (size_t)c * CL_STATE_BYTES) = o;
            const float al = AL[it0 + k], be = BE[it0 + k];
            s0 = al * s0 + be * bflo(v[k].x); s1 = al * s1 + be * bfhi(v[k].x); s2 = al * s2 + be * bflo(v[k].y); s3 = al * s3 + be * bfhi(v[k].y);
            if (w0) { u32x2v o2; o2.x = cvtpk(t0 * os, t1 * os); o2.y = cvtpk(t2 * os, t3 * os); *(GAS u32x2v*)(base + 4096 + (size_t)c * CL_STATE_BYTES) = o2;
                t0 = al * t0 + be * bflo(w[k].x); t1 = al * t1 + be * bfhi(w[k].x); t2 = al * t2 + be * bflo(w[k].y); t3 = al * t3 + be * bfhi(w[k].y); } }
    }
#undef SCAN_LOAD
    __syncthreads();
}

__device__ __forceinline__ void mld_unit(const Ptrs& P, const bf16* CL, const float* M0, LAS unsigned char* lds, int unit, int tid, int wave, int lane, const f32x4 (&gnw)[8]) {
    asm volatile("" : "+v"(tid), "+v"(lane));
    typedef unsigned u32x2v __attribute__((ext_vector_type(2)));
    const int c = unit & (NCH - 1), bh = unit / NCH, b = bh >> 2, hh = bh & 3, row0 = b * T + c * MLC;
    LAS unsigned char* KS = lds; LAS unsigned char* VP = lds + MLC * MLPB; LAS unsigned char* ST = lds + 2 * MLC * MLPB;
    LAS float* G4 = (LAS float*)(lds + 2 * MLC * MLPB + 2 * MLP * MLPB);
    LAS float* AF = G4 + 4 * MLC; LAS float* MXA = AF + 2 * MLC; LAS float* CLA = MXA + 2 * MLC;
    const int i = lane & 15, g = lane >> 4, tq = i >> 2, tp = i & 3;
    const int tl = 16 * wave + i;
    v4u kk_[4], vv_[4], sv[2][5], qf[4];
#pragma unroll
    for (int r = 0; r < 4; ++r) { const int q = tid + 512 * r, s = q >> 4, ce = q & 15;
        kk_[r] = __builtin_nontemporal_load((const GAS v4u*)(P.KB + (size_t)(row0 + s) * MLW + hh * MLD + 8 * ce)); vv_[r] = __builtin_nontemporal_load((const GAS v4u*)(P.PROJ + (size_t)(row0 + s) * NPROJ + PC_V + hh * MLD + 8 * ce)); }
#pragma unroll
    for (int dir = 0; dir < 2; ++dir) { const bf16* st = CL + ((size_t)(dir * 8 + bh) * NCH + c) * (MLP * MLD);
#pragma unroll
        for (int r = 0; r < 5; ++r) { const int q = tid + 512 * r; if (q < MLP * 16) sv[dir][r] = __builtin_nontemporal_load((const GAS v4u*)(st + (size_t)(q >> 4) * MLD + 8 * (q & 15))); } }
#pragma unroll
    for (int ks = 0; ks < 4; ++ks) qf[ks] = __builtin_nontemporal_load((const GAS v4u*)(P.QB + (size_t)(row0 + tl) * MLW + hh * MLD + 32 * ks + 8 * g));
    const float cpv0 = M0[(size_t)bh * NCH + c], cpv1 = M0[(size_t)(8 + bh) * NCH + c];
    ml_load_gates(P.GATES, P.SS, P.bg, row0, hh, G4, tid);
    __syncthreads();
    if (wave < 2) { const int dir = wave; const LAS float* li = G4 + 2 * dir * MLC; const LAS float* lf = li + MLC;
        const int t0 = dir ? MLC - 1 - 2 * lane : 2 * lane, t1 = dir ? t0 - 1 : t0 + 1;
        const float x0 = lf[t0], x1 = lf[t1]; const float S = wave_incl_sum(x0 + x1, lane); const float f0 = S - x1, f1 = S;
        const float a0 = li[t0] - f0, a1 = li[t1] - f1; const float cp = dir ? cpv1 : cpv0;
        AF[dir * MLC + t0] = __expf(a0 - cp); AF[dir * MLC + t1] = __expf(a1 - cp);
        CLA[dir * MLC + t0] = __expf(-(f0 + cp)); CLA[dir * MLC + t1] = __expf(-(f1 + cp)); }
    {
#pragma unroll
      for (int r = 0; r < 4; ++r) { const int q = tid + 512 * r, s = q >> 4, ce = q & 15; *(LAS v4u*)(KS + s * MLPB + 16 * ce) = kk_[r]; *(LAS v4u*)(VP + s * MLPB + 16 * ce) = vv_[r]; } }
    if (tid < MLC) { *(LAS v4u*)(VP + tid * MLPB + 256) = (v4u){0x00003F80u, 0u, 0u, 0u}; *(LAS v4u*)(VP + tid * MLPB + 272) = (v4u){0u, 0u, 0u, 0u}; }
    {
#pragma unroll
      for (int dir = 0; dir < 2; ++dir)
#pragma unroll
          for (int r = 0; r < 5; ++r) { const int q = tid + 512 * r; if (q < MLP * 16) *(LAS v4u*)(ST + dir * MLP * MLPB + (q >> 4) * MLPB + 16 * (q & 15)) = sv[dir][r]; } }
    __syncthreads();
    u32x2v ovp[8];
#pragma unroll
    for (int n = 0; n < 8; ++n) ovp[n] = __builtin_nontemporal_load((const GAS u32x2v*)(P.PROJ + (size_t)(row0 + tl) * NPROJ + PC_O + hh * MLD + 16 * n + 4 * g));
    f32x4 sT[8];
#pragma unroll
    for (int mt = 0; mt < 8; ++mt) { __builtin_amdgcn_sched_barrier(0); sT[mt] = (f32x4){0.f, 0.f, 0.f, 0.f};
#pragma unroll
        for (int ks = 0; ks < 4; ++ks) { const bf16x8 kf = *(const LAS bf16x8*)(KS + (16 * mt + i) * MLPB + 64 * ks + 16 * g);
            sT[mt] = __builtin_amdgcn_mfma_f32_16x16x32_bf16(kf, __builtin_bit_cast(bf16x8, qf[ks]), sT[mt], 0, 0, 0); } }
    f32x4 o[2][9];
#pragma unroll
    for (int d = 0; d < 2; ++d)
#pragma unroll
        for (int n = 0; n < 9; ++n) o[d][n] = (f32x4){0.f, 0.f, 0.f, 0.f};
    const int troff = (4 * g + tq) * MLPB + 8 * tp;
#pragma unroll
    for (int dir = 0; dir < 2; ++dir) {
#pragma unroll
        for (int kk = 0; kk < 4; ++kk) {
            __builtin_amdgcn_sched_barrier(0);
            const bool need = dir == 0 ? (2 * kk <= wave) : (2 * kk + 1 >= wave);
            if (need) {
                float p[8];
#pragma unroll
                for (int h2 = 0; h2 < 2; ++h2) { const int mt = 2 * kk + h2; const f32x4 av = *(const LAS f32x4*)(AF + dir * MLC + 16 * mt + 4 * g);
#pragma unroll
                    for (int r = 0; r < 4; ++r) { const int s = 16 * mt + 4 * g + r; const bool ok = dir == 0 ? (s <= tl) : (s >= tl);
                        p[4 * h2 + r] = ok ? sT[mt][r] * av[r] : 0.f; } }
                v4u pw; pw.x = cvtpk(p[0], p[1]); pw.y = cvtpk(p[2], p[3]); pw.z = cvtpk(p[4], p[5]); pw.w = cvtpk(p[6], p[7]);
                const bf16x8 pb = __builtin_bit_cast(bf16x8, pw);
                const int so = troff + 32 * kk * MLPB;
#pragma unroll
                for (int n = 0; n < 9; ++n) { const bf16x8 va = tr_pair(VP + so + 32 * n, VP + so + 16 * MLPB + 32 * n);
                    o[dir][n] = __builtin_amdgcn_mfma_f32_16x16x32_bf16(va, pb, o[dir][n], 0, 0, 0); }
            }
        }
    }
#pragma unroll
    for (int dir = 0; dir < 2; ++dir) {
#pragma unroll
        for (int ks = 0; ks < 4; ++ks) { __builtin_amdgcn_sched_barrier(0); const bf16x8 qs = __builtin_bit_cast(bf16x8, qf[ks]);
#pragma unroll
            for (int n = 0; n < 9; ++n) { const bf16x8 sa = *(const LAS bf16x8*)(ST + dir * MLP * MLPB + (16 * n + i) * MLPB + 64 * ks + 16 * g);
                o[dir][n] = __builtin_amdgcn_mfma_f32_16x16x32_bf16(sa, qs, o[dir][n], 0, 0, 0); } }
    }
    __builtin_amdgcn_sched_barrier(0);
    float inv[2];
#pragma unroll
    for (int dir = 0; dir < 2; ++dir) { const float den = __shfl(o[dir][8][0], i); inv[dir] = __builtin_amdgcn_rcpf(fmaxf(fabsf(den), CLA[dir * MLC + tl])); }
    float ssq = 0.f;
#pragma unroll
    for (int n = 0; n < 8; ++n)
#pragma unroll
        for (int r = 0; r < 4; ++r) { const float h = o[0][n][r] * inv[0] + o[1][n][r] * inv[1]; o[0][n][r] = h; ssq += h * h; }
    ssq += __shfl_xor(ssq, 16); ssq += __shfl_xor(ssq, 32);
    const float rs = __builtin_amdgcn_rsqf(ssq * (1.0f / MLD) + EPS);
    const size_t row = (size_t)(row0 + tl);
#pragma unroll
    for (int n2 = 0; n2 < 4; ++n2) { u32x2v wy[2]; const bool godd = (g & 1) != 0;
#pragma unroll
      for (int h2 = 0; h2 < 2; ++h2) { const int n = 2 * n2 + h2; const int d = 16 * n + 4 * g; const f32x4 gnv = gnw[n];
        const u32x2v ov = ovp[n];
        const float og0 = bflo(ov.x), og1 = bfhi(ov.x), og2 = bflo(ov.y), og3 = bfhi(ov.y);
#define SIGM(x_) __builtin_amdgcn_rcpf(1.0f + __builtin_amdgcn_exp2f((x_) * -1.4426950408889634f))
        const float y0 = o[0][n][0] * rs * gnv[0] * SIGM(og0), y1 = o[0][n][1] * rs * gnv[1] * SIGM(og1);
        const float y2 = o[0][n][2] * rs * gnv[2] * SIGM(og2), y3 = o[0][n][3] * rs * gnv[3] * SIGM(og3);
#undef SIGM
        wy[h2].x = cvtpk(y0, y1); wy[h2].y = cvtpk(y2, y3); }
      const unsigned rx = __shfl_xor(godd ? wy[0].x : wy[1].x, 16), ry = __shfl_xor(godd ? wy[0].y : wy[1].y, 16);
      v4u oy; if (godd) { oy.x = rx; oy.y = ry; oy.z = wy[1].x; oy.w = wy[1].y; } else { oy.x = wy[0].x; oy.y = wy[0].y; oy.z = rx; oy.w = ry; }
      *(GAS v4u*)(P.Y + row * D + hh * MLD + 16 * (2 * n2 + (godd ? 1 : 0)) + 4 * (g & ~1)) = oy; }
    __syncthreads();
}


constexpr int WG_PITCH = 2048 + 16;
__device__ __forceinline__ void gates_mfma(const Ptrs& P, const bf16* WGH, const bf16* WGL, LAS unsigned char* lds, int first, int end, int stride, int tid, int lane) {
    const int i = lane & 15, g = lane >> 4;
    __syncthreads();
#pragma unroll
    for (int r = 0; r < 8; ++r) { const int q = tid + 512 * r, hl = q >> 11, row = (q >> 7) & 15, ch = q & 127;
        *(LAS v4u*)(lds + hl * 16 * WG_PITCH + row * WG_PITCH + 16 * ch) = *(const GAS v4u*)((hl ? WGL : WGH) + (size_t)row * D + 8 * ch); }
    __syncthreads();
    for (int task = first; task < end; task += stride) {
        const int row0 = (task >> 1) * 16, kh = task & 1;
        f32x4 acc = (f32x4){0.f, 0.f, 0.f, 0.f};
        const bf16* xr = P.XB + (size_t)(row0 + i) * D + 512 * kh + 8 * g; const LAS unsigned char* wh = lds + i * WG_PITCH + (512 * kh + 8 * g) * 2; const LAS unsigned char* wl = wh + 16 * WG_PITCH;
        bf16x8 a[16];
#pragma unroll
        for (int ks = 0; ks < 16; ++ks) a[ks] = *(const GAS bf16x8*)(xr + 32 * ks);
#pragma unroll
        for (int ks = 0; ks < 16; ++ks) {
            const bf16x8 bh = *(const LAS bf16x8*)(wh + 64 * ks), bl = *(const LAS bf16x8*)(wl + 64 * ks);
            acc = __builtin_amdgcn_mfma_f32_16x16x32_bf16(a[ks], bh, acc, 0, 0, 0);
            acc = __builtin_amdgcn_mfma_f32_16x16x32_bf16(a[ks], bl, acc, 0, 0, 0);
        }
#pragma unroll
        for (int r = 0; r < 4; ++r) P.GATES[(size_t)kh * M * NG + (size_t)(row0 + 4 * g + r) * NG + i] = acc[r];
    }
    __syncthreads();
}

constexpr int NA_ROWS = 9, NA_KS = 0, NA_VS = NA_ROWS * 64 * 128, NA_BT = 2 * NA_VS;
__device__ __forceinline__ void na_phase(const Ptrs& P, LAS unsigned char* lds, int first, int end, int stride, int tid, int wave, int lane) {
    typedef unsigned u32x2v __attribute__((ext_vector_type(2)));
    if (first >= end) return;
    LAS float* BT = (LAS float*)(lds + NA_BT);
    const int i = lane & 15, g = lane >> 4, qt = wave & 3, c = 16 * qt + i;
    const int cs = min(max(c - 8, 0), GW - 16), ws = qt == 0 ? 0 : qt == 1 ? 8 : qt == 2 ? 24 : 32;
    const int skey = tid >> 3, sch = tid & 7;
    const int sdst = skey * 128 + ((sch ^ (skey & 7)) << 4);
    const f32x4 gq0 = *(const GAS f32x4*)(P.gq + 8 * g) * *(const GAS f32x4*)(P.gk + 8 * g), gq1 = *(const GAS f32x4*)(P.gq + 8 * g + 4) * *(const GAS f32x4*)(P.gk + 8 * g + 4),
        gq2 = *(const GAS f32x4*)(P.gq + 32 + 8 * g) * *(const GAS f32x4*)(P.gk + 32 + 8 * g), gq3 = *(const GAS f32x4*)(P.gq + 32 + 8 * g + 4) * *(const GAS f32x4*)(P.gk + 32 + 8 * g + 4);
    const int kq = 4 * g + (i >> 2), tp = i & 3;
    int voff[4];
#pragma unroll
    for (int md = 0; md < 4; ++md) voff[md] = (ws + kq) * 128 + (((2 * md + (tp >> 1)) ^ (kq & 7)) << 4) + 8 * (tp & 1);
    int koff[2];
#pragma unroll
    for (int ks = 0; ks < 2; ++ks) koff[ks] = (ws + i) * 128 + (((4 * ks + g) ^ (i & 7)) << 4);
    float okf[8]; int bto[8];
#pragma unroll
    for (int h = 0; h < 2; ++h)
#pragma unroll
        for (int r = 0; r < 4; ++r) { const int kc = ws + 16 * h + 4 * g + r; okf[4 * h + r] = (kc >= cs && kc < cs + 16) ? 1.f : 0.f; bto[4 * h + r] = (kc - c + 15) & 31; }
    v4u pk[NA_ROWS], pv[NA_ROWS], pq0, pq1;
#define NA_NEED(kr_, bhd_, pra_, pbhd_) ((kr_) < GROWS && !((bhd_) == (pbhd_) && (kr_) >= (pra_) && (kr_) <= (pra_) + 8))
#define NA_LOAD(unit_, pra_, pbhd_) do { const int j_ = (unit_) & 63, bhd_ = (unit_) >> 6, b_ = bhd_ >> 3, hd_ = bhd_ & 7, r0_ = 2 * j_, ra_ = min(max(r0_ - 4, 0), GROWS - 8); \
        _Pragma("unroll") for (int rr = 0; rr < NA_ROWS; ++rr) { const int kr = ra_ + rr; if (NA_NEED(kr, bhd_, pra_, pbhd_)) { const size_t ktok = (size_t)b_ * T + kr * GW + skey; \
            pk[rr] = *(const GAS v4u*)(P.PROJ + ktok * NPROJ + PC_KN + hd_ * NAD + 8 * sch); pv[rr] = *(const GAS v4u*)(P.PROJ + ktok * NPROJ + PC_VN + hd_ * NAD + 8 * sch); } } \
        const size_t qtok_ = (size_t)b_ * T + (r0_ + (wave >> 2)) * GW + c; \
        pq0 = *(const GAS v4u*)(P.PROJ + qtok_ * NPROJ + PC_QN + hd_ * NAD + 8 * g); pq1 = *(const GAS v4u*)(P.PROJ + qtok_ * NPROJ + PC_QN + hd_ * NAD + 32 + 8 * g); } while (0)
    int pra = -100, pbhd = -1;
#pragma unroll
    for (int rr = 0; rr < NA_ROWS; ++rr) { pk[rr] = (v4u){0u, 0u, 0u, 0u}; pv[rr] = (v4u){0u, 0u, 0u, 0u}; }
    NA_LOAD(first, pra, pbhd);
#pragma unroll 1
    for (int unit = first; unit < end; unit += stride) {
        const int j = unit & 63, bhd = unit >> 6, b = bhd >> 3, hd = bhd & 7, r0 = 2 * j, ra = min(max(r0 - 4, 0), GROWS - 8);
        const int qrow = r0 + (wave >> 2), rsw = min(max(qrow - 4, 0), GROWS - 8);
        const size_t qtok = (size_t)b * T + qrow * GW + c;
        __syncthreads();
        if (bhd != pbhd && tid < 480) { const int dr = tid >> 5, dc = tid & 31; BT[tid] = dc < 31 ? P.rpb[(hd * 15 + dr) * 31 + dc] * 1.4426950408889634f : 0.f; }
#pragma unroll
        for (int rr = 0; rr < NA_ROWS; ++rr) { const int krs = ra + rr; if (!NA_NEED(krs, bhd, pra, pbhd)) continue; const int sl = krs % 9; const v4u kv = pk[rr];
            float x[8]; x[0] = bflo(kv.x); x[1] = bfhi(kv.x); x[2] = bflo(kv.y); x[3] = bfhi(kv.y); x[4] = bflo(kv.z); x[5] = bfhi(kv.z); x[6] = bflo(kv.w); x[7] = bfhi(kv.w);
            float ss = (x[0] * x[0] + x[1] * x[1]) + (x[2] * x[2] + x[3] * x[3]) + (x[4] * x[4] + x[5] * x[5]) + (x[6] * x[6] + x[7] * x[7]);
            ss += __shfl_xor(ss, 1); ss += __shfl_xor(ss, 2); ss += __shfl_xor(ss, 4);
            const float rk = __builtin_amdgcn_rsqf(ss * (1.0f / NAD) + EPS);
            v4u kn; kn.x = cvtpk(x[0] * rk, x[1] * rk); kn.y = cvtpk(x[2] * rk, x[3] * rk); kn.z = cvtpk(x[4] * rk, x[5] * rk); kn.w = cvtpk(x[6] * rk, x[7] * rk);
            *(LAS v4u*)(lds + NA_KS + sl * 8192 + sdst) = kn; *(LAS v4u*)(lds + NA_VS + sl * 8192 + sdst) = pv[rr]; }
        pra = ra; pbhd = bhd;
        bf16x8 qf[2];
        { float x[16]; x[0] = bflo(pq0.x); x[1] = bfhi(pq0.x); x[2] = bflo(pq0.y); x[3] = bfhi(pq0.y); x[4] = bflo(pq0.z); x[5] = bfhi(pq0.z); x[6] = bflo(pq0.w); x[7] = bfhi(pq0.w);
          x[8] = bflo(pq1.x); x[9] = bfhi(pq1.x); x[10] = bflo(pq1.y); x[11] = bfhi(pq1.y); x[12] = bflo(pq1.z); x[13] = bfhi(pq1.z); x[14] = bflo(pq1.w); x[15] = bfhi(pq1.w);
          float ss = 0.f;
#pragma unroll
          for (int k = 0; k < 16; ++k) ss += x[k] * x[k];
          ss += __shfl_xor(ss, 16); ss += __shfl_xor(ss, 32);
          const float rq = (0.125f * 1.4426950408889634f) * __builtin_amdgcn_rsqf(ss * (1.0f / NAD) + EPS);
          v4u a, bq; a.x = cvtpk(x[0] * rq * gq0[0], x[1] * rq * gq0[1]); a.y = cvtpk(x[2] * rq * gq0[2], x[3] * rq * gq0[3]); a.z = cvtpk(x[4] * rq * gq1[0], x[5] * rq * gq1[1]); a.w = cvtpk(x[6] * rq * gq1[2], x[7] * rq * gq1[3]);
          bq.x = cvtpk(x[8] * rq * gq2[0], x[9] * rq * gq2[1]); bq.y = cvtpk(x[10] * rq * gq2[2], x[11] * rq * gq2[3]); bq.z = cvtpk(x[12] * rq * gq3[0], x[13] * rq * gq3[1]); bq.w = cvtpk(x[14] * rq * gq3[2], x[15] * rq * gq3[3]);
          qf[0] = __builtin_bit_cast(bf16x8, a); qf[1] = __builtin_bit_cast(bf16x8, bq); }
        __syncthreads();
        if (unit + stride < end) NA_LOAD(unit + stride, pra, pbhd);
        f32x4 o[4];
#pragma unroll
        for (int md = 0; md < 4; ++md) o[md] = (f32x4){0.f, 0.f, 0.f, 0.f};
        float den = 0.f;
#pragma unroll 1
        for (int rr = rsw - ra; rr < rsw - ra + 8; ++rr) {
            const int kr = ra + rr, sl = kr % 9;
            f32x4 s[2];
#pragma unroll
            for (int h = 0; h < 2; ++h) { s[h] = (f32x4){0.f, 0.f, 0.f, 0.f};
#pragma unroll
                for (int ks = 0; ks < 2; ++ks) { const bf16x8 kf = *(const LAS bf16x8*)(lds + NA_KS + sl * 8192 + h * 2048 + koff[ks]); s[h] = __builtin_amdgcn_mfma_f32_16x16x32_bf16(kf, qf[ks], s[h], 0, 0, 0); } }
            const LAS float* btr = BT + (kr - qrow + 7) * 32; float p[8];
#pragma unroll
            for (int h = 0; h < 2; ++h)
#pragma unroll
                for (int r = 0; r < 4; ++r) { p[4 * h + r] = __builtin_amdgcn_exp2f(s[h][r] + btr[bto[4 * h + r]]) * okf[4 * h + r]; den += p[4 * h + r]; }
            v4u pw; pw.x = cvtpk(p[0], p[1]); pw.y = cvtpk(p[2], p[3]); pw.z = cvtpk(p[4], p[5]); pw.w = cvtpk(p[6], p[7]);
            const bf16x8 pb = __builtin_bit_cast(bf16x8, pw);
#pragma unroll
            for (int md = 0; md < 4; ++md) { const bf16x8 va = tr_pair(lds + NA_VS + sl * 8192 + voff[md], lds + NA_VS + sl * 8192 + 2048 + voff[md]);
                o[md] = __builtin_amdgcn_mfma_f32_16x16x32_bf16(va, pb, o[md], 0, 0, 0); }
        }
        den += __shfl_xor(den, 16); den += __shfl_xor(den, 32);
        const float inv = __builtin_amdgcn_rcpf(den);
#pragma unroll
        for (int m2 = 0; m2 < 2; ++m2) { const bool godd = (g & 1) != 0;
            const unsigned a0 = cvtpk(o[2 * m2][0] * inv, o[2 * m2][1] * inv), a1 = cvtpk(o[2 * m2][2] * inv, o[2 * m2][3] * inv), b0 = cvtpk(o[2 * m2 + 1][0] * inv, o[2 * m2 + 1][1] * inv), b1 = cvtpk(o[2 * m2 + 1][2] * inv, o[2 * m2 + 1][3] * inv);
            const unsigned rx = __shfl_xor(godd ? a0 : b0, 16), ry = __shfl_xor(godd ? a1 : b1, 16);
            v4u oy; if (godd) { oy.x = rx; oy.y = ry; oy.z = b0; oy.w = b1; } else { oy.x = a0; oy.y = a1; oy.z = rx; oy.w = ry; }
            *(GAS v4u*)(P.Y + qtok * D + MLW + hd * NAD + 16 * (2 * m2 + (godd ? 1 : 0)) + 4 * (g & ~1)) = oy; }
    }
#undef NA_LOAD
#undef NA_NEED
    __syncthreads();
}

__device__ __forceinline__ void final_norm(const Ptrs& P, int gw, int NGW, int lane) {
    const GAS f32x4* gr = (const GAS f32x4*)P.gf + lane; f32x4 gv[4];
#pragma unroll
    for (int j = 0; j < 4; ++j) gv[j] = gr[64 * j];
    for (int m0 = gw; m0 < M; m0 += 4 * NGW) {
        f32x4 v[4][4]; float rs[4];
#pragma unroll
        for (int r = 0; r < 4; ++r) { const int mm = (m0 + r * NGW) < M ? (m0 + r * NGW) : m0; GAS f32x4* xr = (GAS f32x4*)(P.out + (size_t)mm * D) + lane;
#pragma unroll
            for (int j = 0; j < 4; ++j) v[r][j] = xr[64 * j];
            rs[r] = pg8::rstd_from_ss(P.SS, mm); }
#pragma unroll
        for (int r = 0; r < 4; ++r) { const int mm = m0 + r * NGW; if (mm < M) { GAS f32x4* xr = (GAS f32x4*)(P.out + (size_t)mm * D) + lane;
#pragma unroll
            for (int j = 0; j < 4; ++j) xr[64 * j] = v[r][j] * rs[r] * gv[j]; } }
    }
}

#define MAKE_P() Ptrs P; do { \
    P.x = args.in[0]; P.g1 = args.in[1]; P.w1g = args.in[2]; P.w1u = args.in[3]; P.w1d = args.in[4]; P.gm = args.in[5]; P.win = args.in[6]; P.bg = args.in[7]; P.cw = args.in[8]; P.cb = args.in[9]; \
    P.wq = args.in[10]; P.wk = args.in[11]; P.gn = args.in[12]; P.gq = args.in[13]; P.gk = args.in[14]; P.rpb = args.in[15]; P.wout = args.in[16]; P.g2 = args.in[17]; P.w2g = args.in[18]; P.w2u = args.in[19]; \
    P.w2d = args.in[20]; P.gf = args.in[21]; P.out = args.out; \
    P.W1T = (bf16*)(ws + WS_W1T); P.W1DT = (bf16*)(ws + WS_W1DT); P.WINT = (bf16*)(ws + WS_WINT); P.WOUTT = (bf16*)(ws + WS_WOUTT); P.W2T = (bf16*)(ws + WS_W2T); P.W2DT = (bf16*)(ws + WS_W2DT); \
    P.XB = (bf16*)(ws + WS_XB); P.QB = (bf16*)args.out; P.KB = (bf16*)((unsigned char*)args.out + 16 * MiB); P.H = (bf16*)(ws + WS_HP); P.PROJ = (bf16*)(ws + WS_HP); P.Y = (bf16*)(ws + WS_Y); \
    P.WQT = (bf16*)(ws + WS_WQT); P.WKT = (bf16*)(ws + WS_WQT + 131072); P.WGH = (bf16*)(ws + WS_WG); P.WGL = (bf16*)(ws + WS_WG + 32768); P.SS = (float*)(ws + WS_SS); P.GATES = (float*)(ws + WS_GATES); } while (0)
#ifndef MK_N_LAUNCHES
#define MK_N_LAUNCHES 1
#endif
constexpr int NA_UNITS_P4 = 768;
constexpr int NPH = 10;
constexpr int N_LAUNCHES = MK_N_LAUNCHES;
struct Args { const float* in[22]; float* out; unsigned char* ws; int ph_lo, ph_hi; };
__global__ void __launch_bounds__(NWAVES * 64, 2) fwd_megakernel(Args args) {
    extern __shared__ __attribute__((aligned(16))) unsigned char lds_raw[];
    LAS unsigned char* lds = (LAS unsigned char*)lds_raw;
    volatile LAS unsigned* MISC = (volatile LAS unsigned*)(lds + MISC_OFF);
    const int tid = threadIdx.x, lane = tid & 63, wave = __builtin_amdgcn_readfirstlane(tid >> 6);
    const int G = gridDim.x, bx = blockIdx.x, vcu = (G % 8 == 0) ? (bx % 8) * (G / 8) + bx / 8 : bx;
    const int gw = vcu * NWAVES + wave, NGW = G * NWAVES, gtid = vcu * NWAVES * 64 + tid, NGT = G * NWAVES * 64;
    unsigned char* ws = args.ws;
    gu32* ctl = (gu32*)(ws + WS_CTL);
    for (int u = tid; u < (LDS_BYTES - LDSCTL_OFF) / 4; u += NWAVES * 64) ((LAS unsigned*)(lds + LDSCTL_OFF))[u] = 0u;
    __syncthreads();
    XcdBarrier bar; bar.bar = (unsigned*)(ctl + CW_BAR); bar.x = 0; bar.st = nullptr;
    if (N_LAUNCHES == 1) bar = xcd_barrier_post((unsigned*)(ctl + CW_BAR), MISC + 8);
#define GRID_BAR() do { if (N_LAUNCHES == 1) xcd_barrier(bar); } while (0)
    const bool tied = (G == 256);
    const int pm_own = 8 * (bx % 8) + (bx / 8) % 8;
    LAS float* const RT = (LAS float*)(lds + RING_BYTES);
#define FILL_RT() do { if (tied) { __syncthreads(); if (tid < 256) RT[tid] = pg8::rstd_from_ss(P.SS, 256 * pm_own + tid); __syncthreads(); } } while (0)
    const int lo = args.ph_lo, hi = args.ph_hi;
#ifndef PHASE_MASK
#define PHASE_MASK 0xFFFF
#endif
#define IN(k) (((PHASE_MASK >> (k)) & 1) && lo <= (k) && (k) < hi)
#define BOTH(k) (IN(k) && IN((k) + 1))
#ifndef PHASE_DUP
#define PHASE_DUP 0
#endif
#define REP(k) for (int rep_ = 0; rep_ < (((PHASE_DUP >> (k)) & 1) ? 2 : 1); ++rep_)

    if (IN(0)) { MAKE_P(); REP(0) p0_prologue(P, lds, gw, NGW, lane, wave, gtid, NGT); if (BOTH(0)) GRID_BAR(); }
    if (IN(1)) { MAKE_P(); REP(1) { pg8::Gemm g{P.XB, P.W1T, M, NFF2, D}; pg8::StaticOrder S; S.init(M, NFF2, G, bx); FILL_RT(); pg8::EpiSwiGLU E{P.H, FF, P.SS, tied ? (const LAS float*)RT : (const LAS float*)nullptr};
        pg8::gemm_phase<pg8::EpiSwiGLU, pg8::StaticOrder, true, true>(lds + RING_OFF, g, S, E); }
        if (bx >= G / 2) p0_deferred(P, lds, 0, 5760, (bx - G / 2) * NWAVES + wave, (G / 2) * NWAVES, lane, wave);
        if (BOTH(1)) GRID_BAR(); }
    if (IN(2)) { MAKE_P(); REP(2) { pg8::Gemm g{P.H, P.W1DT, M, D, FF}; pg8::StaticOrder S; S.init(M, D, G, bx); pg8::EpiResidG E{P.XB, P.SS, 0.5f, D, P.WGH, P.WGL, P.GATES, M};
        pg8::gemm_phase<pg8::EpiResidG, pg8::StaticOrder, true, true>(lds + RING_OFF, g, S, E); } if (BOTH(2)) GRID_BAR(); }
    if (IN(3)) { MAKE_P(); REP(3) {
        pg8::Gemm g{P.XB, P.WINT, M, NPROJ, D}; pg8::StaticOrder S; S.init(M, NPROJ, G, bx); FILL_RT(); pg8::EpiProj E{P.PROJ, NPROJ, P.SS, tied ? (const LAS float*)RT : (const LAS float*)nullptr};
        pg8::gemm_phase<pg8::EpiProj, pg8::StaticOrder, true, true>(lds + RING_OFF, g, S, E); } if (BOTH(3)) GRID_BAR(); }
    if (IN(4)) { MAKE_P(); REP(4) { { const int hh = (vcu / NCH) & 3, i = lane & 15, g = lane >> 4;
          bf16x8 aq[4], ak[4];
#pragma unroll
    for (int ks = 0; ks < 4; ++ks) { aq[ks] = *(const GAS bf16x8*)(P.WQT + (size_t)(hh * MLD + 16 * wave + i) * MLD + 32 * ks + 8 * g); ak[ks] = *(const GAS bf16x8*)(P.WKT + (size_t)(hh * MLD + 16 * wave + i) * MLD + 32 * ks + 8 * g); }
          for (int unit = vcu; unit < 8 * NCH; unit += G) mlb_unit(P, (bf16*)(ws + WS_CL), (float*)(ws + WS_CHS), lds, unit, tid, wave, lane, aq, ak); }
        na_phase(P, lds, 3 * vcu, 3 * vcu + 3, 1, tid, wave, lane); } if (BOTH(4)) GRID_BAR(); }
    if (IN(5)) { MAKE_P();
        if (!(vcu & 1)) ml_scan((bf16*)(ws + WS_CL), (const float*)(ws + WS_CHS), (float*)(ws + WS_M0), lds, vcu >> 1, tid);
        else { na_phase(P, lds, NA_UNITS_P4 + 2 * (vcu >> 1), NA_UNITS_P4 + 2 * (vcu >> 1) + 2, 1, tid, wave, lane);
            p0_deferred(P, lds, 5760, 6272, (vcu >> 1) * NWAVES + wave, 128 * NWAVES, lane, wave); }         if (BOTH(5)) GRID_BAR(); }
    if (IN(6)) { MAKE_P(); REP(6) { { f32x4 gnw[8]; const int hh = (vcu / NCH) & 3, g = lane >> 4;
#pragma unroll
          for (int n = 0; n < 8; ++n) gnw[n] = *(const GAS f32x4*)(P.gn + hh * MLD + 16 * n + 4 * g);
          for (int unit = vcu; unit < 8 * NCH; unit += G) mld_unit(P, (const bf16*)(ws + WS_CL), (const float*)(ws + WS_M0), lds, unit, tid, wave, lane, gnw); } } if (BOTH(6)) GRID_BAR(); }
    if (IN(7)) { MAKE_P(); pg8::Gemm g{P.Y, P.WOUTT, M, D, D}; pg8::StaticOrder S; S.init(M, D, G, bx); pg8::EpiResid<true, false, true> E{P.XB, nullptr, P.XB, P.SS, 1.0f, D, nullptr, nullptr, nullptr};
        pg8::gemm_phase<pg8::EpiResid<true, false, true>, pg8::StaticOrder, true, true>(lds + RING_OFF, g, S, E); if (BOTH(7)) GRID_BAR(); }
    if (IN(8)) { MAKE_P(); REP(8) { pg8::Gemm g{P.XB, P.W2T, M, NFF2, D}; pg8::StaticOrder S; S.init(M, NFF2, G, bx); FILL_RT(); pg8::EpiSwiGLU E{P.H, FF, P.SS, tied ? (const LAS float*)RT : (const LAS float*)nullptr};
        pg8::gemm_phase<pg8::EpiSwiGLU, pg8::StaticOrder, true, true>(lds + RING_OFF, g, S, E); }
        if (bx >= G / 2) p0_deferred(P, lds, 6272, 7680, (bx - G / 2) * NWAVES + wave, (G / 2) * NWAVES, lane, wave);
        if (BOTH(8)) GRID_BAR(); }
    if (IN(9)) { MAKE_P(); pg8::Gemm g{P.H, P.W2DT, M, D, FF}; pg8::StaticOrder S; S.init(M, D, G, bx); pg8::EpiResid<true, true, false, true, 1> E{P.XB, P.out, nullptr, P.SS, 0.5f, D, (float*)(ws + WS_XS), (unsigned*)(ctl + CW_PAN), P.gf};
        pg8::gemm_phase<pg8::EpiResid<true, true, false, true, 1>, pg8::StaticOrder, true, true>(lds + RING_OFF, g, S, E); }
#undef IN
#undef BOTH
#undef GRID_BAR
#undef FILL_RT
}

extern "C" void kernel_launch(void* const* d_in, const int* in_sizes, int n_in, void* d_out, int out_size, void* d_ws, size_t ws_size, hipStream_t stream) {
    static int grid = 0;
    if (grid == 0) {
        if (n_in != 22 || in_sizes[0] != M * D || out_size != M * D || ws_size < WS_END) { fprintf(stderr, "kernel_launch: unexpected shapes (n_in %d, in0 %d, out %d, ws %zu)\n", n_in, n_in > 0 ? in_sizes[0] : -1, out_size, ws_size); grid = -1; return; }
        int dev = 0, cus = 0, per_cu = 0;
        if (hipGetDevice(&dev) != hipSuccess || hipDeviceGetAttribute(&cus, hipDeviceAttributeMultiprocessorCount, dev) != hipSuccess) { grid = -1; return; }
        if (hipFuncSetAttribute((const void*)fwd_megakernel, hipFuncAttributeMaxDynamicSharedMemorySize, LDS_BYTES) != hipSuccess) { fprintf(stderr, "kernel_launch: hipFuncSetAttribute failed\n"); grid = -1; return; }
        if (hipOccupancyMaxActiveBlocksPerMultiprocessor(&per_cu, (const void*)fwd_megakernel, NWAVES * 64, LDS_BYTES) != hipSuccess || per_cu < 1) { fprintf(stderr, "kernel_launch: occupancy query says %d blocks per CU\n", per_cu); per_cu = 1; }
        (void)hipGetLastError();
        if (cus < 256) { fprintf(stderr, "kernel_launch: this kernel is built for the 256-CU MI355X (one workgroup per CU, 256 workgroups); the device reports %d CUs; nothing launched\n", cus); grid = -1; return; }
        grid = 256;
    }
    if (grid < 0) return;
    (void)hipMemsetAsync((char*)d_ws + WS_CTL, 0, 65536, stream);
    Args a{};
    for (int i = 0; i < 22; ++i) a.in[i] = (const float*)d_in[i];
    a.out = (float*)d_out; a.ws = (unsigned char*)d_ws;
    if (N_LAUNCHES == 1) { a.ph_lo = 0; a.ph_hi = NPH; hipLaunchKernelGGL(fwd_megakernel, dim3(grid), dim3(NWAVES * 64), LDS_BYTES, stream, a); }
    else for (int li = 0; li < NPH; ++li) { a.ph_lo = li; a.ph_hi = li + 1; hipLaunchKernelGGL(fwd_megakernel, dim3(grid), dim3(NWAVES * 64), LDS_BYTES, stream, a); }
}
```

```cpp
#include <hip/hip_runtime.h>
#include <cstdio>
#include <cstdint>
namespace pg8 {
#define PG8_LAS __attribute__((address_space(3)))
typedef unsigned short bf16_t;
typedef short bf16x8 __attribute__((ext_vector_type(8)));
typedef float f32x4 __attribute__((ext_vector_type(4)));
typedef unsigned u32x4 __attribute__((ext_vector_type(4)));
constexpr int BM = 256, BK = 64, HALF = 128, HTB = HALF * BK * 2  , STAGE_BYTES = 8 * HTB, NXCD = 8, WGM = 8;

__host__ __device__ __forceinline__ int lds_byte(int r, int c) { const int st = (r >> 4) * 2 + (c >> 5), rr = r & 15, cc = c & 31, ob = rr * 64 + cc * 2; return st * 1024 + (ob ^ (((ob >> 9) & 1) << 5)); }
__host__ __device__ __forceinline__ void stage_rc(int b, int& R, int& C) { const int st = b / 1024, sb = b % 1024, swz = sb ^ (((sb >> 9) & 1) << 5); R = (st >> 1) * 16 + swz / 64; C = (st & 1) * 32 + (swz % 64) / 2; }
__host__ __device__ __forceinline__ int perm32(int rho) { const int n = rho >> 4, i = rho & 15; return 8 * (i >> 2) + 4 * n + (i & 3); }

struct Unit { int pm, pn; };
struct Gemm { const bf16_t* A; const bf16_t* Bt; int M, N, K; };

struct StaticOrder {
    int nM, nN, nwg, G, c; bool tied; int pm0, pn0;
    __host__ __device__ void init(int M, int N, int G_, int c_) { nM = M / BM; nN = N / BM; nwg = nM * nN; G = G_; c = c_;
        tied = (G == 256 && nM == 64); pm0 = 8 * (c % 8) + (c / 8) % 8; pn0 = c >> 6; }
    __host__ __device__ bool next(int i, Unit& u) const {
        if (tied) { if (256 * i + c >= nwg) return false; u.pm = pm0; u.pn = 4 * i + pn0; return true; }
        const long L = (long)i * G + c; if (L >= nwg) return false;
        int wgid = (int)L; { const int q = nwg / NXCD, r = nwg % NXCD, xcd = wgid % NXCD, off = wgid / NXCD; wgid = (xcd < r ? xcd * (q + 1) : r * (q + 1) + (xcd - r) * q) + off; }
        const int nig = WGM * nN, gid = wgid / nig, fm = gid * WGM, gsz = (nM - fm) < WGM ? (nM - fm) : WGM;
        u.pm = fm + ((wgid % nig) % gsz); u.pn = (wgid % nig) / gsz; return true;
    }
    __device__ __forceinline__ void a_ready(const Unit&) const {}
    __device__ __forceinline__ void done(const Unit&) const {}
};

typedef float f32x2 __attribute__((ext_vector_type(2))); typedef __bf16 bf16x2v __attribute__((ext_vector_type(2)));
__device__ __forceinline__ unsigned cvt_pk_bf16(float lo, float hi) { f32x2 v = {lo, hi}; bf16x2v b = __builtin_convertvector(v, bf16x2v); return __builtin_bit_cast(unsigned, b); }
constexpr float RMS_EPS = 1e-6f;
__device__ __forceinline__ float rstd_from_ss(const float* ss, int row) {
    const f32x4* p = (const f32x4*)(ss + (size_t)row * 16);
    const f32x4 a = p[0], b = p[1], c = p[2], d = p[3];
    const float s = ((a[0] + a[1]) + (a[2] + a[3])) + ((b[0] + b[1]) + (b[2] + b[3])) + ((c[0] + c[1]) + (c[2] + c[3])) + ((d[0] + d[1]) + (d[2] + d[3]));
    return __builtin_amdgcn_rsqf(s * (1.0f / 1024.0f) + RMS_EPS);
}
__device__ __forceinline__ float rstd_from_ss4(const float* ss, int row, int fq) {
    const f32x4 a = *(const f32x4*)(ss + (size_t)row * 16 + 4 * fq);
    float s = (a[0] + a[1]) + (a[2] + a[3]); s += __shfl_xor(s, 16); s += __shfl_xor(s, 32);
    return __builtin_amdgcn_rsqf(s * (1.0f / 1024.0f) + RMS_EPS);
}
__device__ __forceinline__ f32x2 silu_mul2(f32x2 g, f32x2 u) {
    const f32x2 t = g * -1.4426950408889634f; f32x2 e; e.x = __builtin_amdgcn_exp2f(t.x); e.y = __builtin_amdgcn_exp2f(t.y);
    const f32x2 d = e + 1.0f; f32x2 r; r.x = __builtin_amdgcn_rcpf(d.x); r.y = __builtin_amdgcn_rcpf(d.y);
    return (g * r) * u;
}
struct EpiSwiGLU {
    static constexpr bool PERM = true, AFTER_DRAIN = false, INIT = false, LDSBASE = false;
    bf16_t* H; int ldh; const float* ss; const PG8_LAS float* rt;
    __device__ __forceinline__ void operator()(const f32x4 (&acc)[2][2][4][2], const Unit& u, int wr, int wc, int fr, int fq) const {
        const int row0 = u.pm * BM + wr * 64 + fr, col0 = u.pn * HALF + wc * 32 + 8 * fq;
        float rsv[8];
#pragma unroll
        for (int k = 0; k < 8; ++k) rsv[k] = rt[(row0 + (k >> 2) * HALF + (k & 3) * 16) & 255];
#pragma unroll
        for (int ai = 0; ai < 2; ++ai)
#pragma unroll
            for (int m = 0; m < 4; ++m) { const int row = row0 + ai * HALF + m * 16; const float rs = rsv[ai * 4 + m];
                const f32x4 g0 = acc[ai][0][m][0] * rs, g1 = acc[ai][0][m][1] * rs, u0 = acc[ai][1][m][0] * rs, u1 = acc[ai][1][m][1] * rs;
                const f32x2 h0 = silu_mul2((f32x2){g0[0], g0[1]}, (f32x2){u0[0], u0[1]}), h1 = silu_mul2((f32x2){g0[2], g0[3]}, (f32x2){u0[2], u0[3]});
                const f32x2 h2 = silu_mul2((f32x2){g1[0], g1[1]}, (f32x2){u1[0], u1[1]}), h3 = silu_mul2((f32x2){g1[2], g1[3]}, (f32x2){u1[2], u1[3]});
                u32x4 w; w.x = cvt_pk_bf16(h0.x, h0.y); w.y = cvt_pk_bf16(h1.x, h1.y); w.z = cvt_pk_bf16(h2.x, h2.y); w.w = cvt_pk_bf16(h3.x, h3.y);
                *(u32x4*)(H + (size_t)row * ldh + col0) = w; }
    }
};
__device__ __forceinline__ u32x4 lds_resid8(const PG8_LAS unsigned char* lds, int ai, int bj, int wr, int wc, int m, int fr, int fq) {
    const int hi = wc >> 1, slot = bj == 0 ? 4 + 2 * ai + hi : (ai == 0 ? hi : (hi ? 8 : 2));
    return *(const PG8_LAS u32x4*)(lds + slot * HTB + lds_byte(wr * 64 + m * 16 + fr, (wc & 1) * 32 + fq * 8));
}
__device__ __forceinline__ void add_resid(f32x4 (&acc)[2][2][4][2], float alpha, const PG8_LAS unsigned char* lds, int wr, int wc, int fr, int fq) {
#pragma unroll
    for (int ai = 0; ai < 2; ++ai)
#pragma unroll
        for (int m = 0; m < 4; ++m)
#pragma unroll
            for (int bj = 0; bj < 2; ++bj) { const u32x4 w = lds_resid8(lds, ai, bj, wr, wc, m, fr, fq); f32x4 b0, b1;
                b0[0] = __builtin_bit_cast(float, w.x << 16); b0[1] = __builtin_bit_cast(float, w.x & 0xffff0000u); b0[2] = __builtin_bit_cast(float, w.y << 16); b0[3] = __builtin_bit_cast(float, w.y & 0xffff0000u);
                b1[0] = __builtin_bit_cast(float, w.z << 16); b1[1] = __builtin_bit_cast(float, w.z & 0xffff0000u); b1[2] = __builtin_bit_cast(float, w.w << 16); b1[3] = __builtin_bit_cast(float, w.w & 0xffff0000u);
                acc[ai][bj][m][0] = acc[ai][bj][m][0] * alpha + b0; acc[ai][bj][m][1] = acc[ai][bj][m][1] * alpha + b1; }
}
template <bool BASEBF, bool OUTF32, bool OUTBF, bool FUSENORM = false, int ALPHA2 = 2> struct EpiResid {
    static constexpr bool PERM = true, AFTER_DRAIN = true, INIT = false, LDSBASE = true;
    static_assert(BASEBF, "the residual stream is bf16");
    __device__ __forceinline__ const char* base_ptr() const { return (const char*)base; }
    const void* base; float* out; bf16_t* xb; float* ss; float alpha; int ldc;
    float* xs; unsigned* pcnt; const float* gain;
    __device__ __forceinline__ void fused(f32x4 (&acc)[2][2][4][2], const Unit& u, int wr, int wc, int fr, int fq, PG8_LAS unsigned char* lds, int wid, int lane) const {
        add_resid(acc, 0.5f * ALPHA2, lds, wr, wc, fr, fq);
        if constexpr (FUSENORM) {
            const int row0f = u.pm * BM + wr * 64 + fr, col0f = u.pn * BM + wc * 32 + 8 * fq;
#pragma unroll
            for (int ai = 0; ai < 2; ++ai)
#pragma unroll
                for (int m = 0; m < 4; ++m) { const int row = row0f + ai * HALF + m * 16; float q = 0.f;
#pragma unroll
                    for (int bj = 0; bj < 2; ++bj) { const f32x4 o0 = acc[ai][bj][m][0], o1 = acc[ai][bj][m][1];
                        q += ((o0[0] * o0[0] + o0[1] * o0[1]) + (o0[2] * o0[2] + o0[3] * o0[3])) + ((o1[0] * o1[0] + o1[1] * o1[1]) + (o1[2] * o1[2] + o1[3] * o1[3])); }
                    q += __shfl_xor(q, 16); q += __shfl_xor(q, 32);
                    if (fq == 0) __hip_atomic_store(xs + (size_t)row * 16 + u.pn * 4 + wc, q, __ATOMIC_RELAXED, __HIP_MEMORY_SCOPE_AGENT); }
            asm volatile("s_waitcnt vmcnt(0)" ::: "memory");
            unsigned* cnt = pcnt + 64 * u.pm;
            if (fr == 0 && fq == 0) (void)__hip_atomic_fetch_add(cnt, 1u, __ATOMIC_RELAXED, __HIP_MEMORY_SCOPE_AGENT);
            if (wr == 0 && wc == 0) { unsigned sp = 0;
                while ((unsigned)__builtin_amdgcn_readfirstlane(__hip_atomic_load(cnt, __ATOMIC_RELAXED, __HIP_MEMORY_SCOPE_AGENT)) < 32u) { __builtin_amdgcn_s_sleep(2); if (++sp > (1u << 20)) break; }
                __builtin_amdgcn_fence(__ATOMIC_ACQUIRE, "agent");
                asm volatile("s_waitcnt vmcnt(0)" ::: "memory"); }
            asm volatile("s_waitcnt lgkmcnt(0)" ::: "memory"); __builtin_amdgcn_s_barrier(); asm volatile("" ::: "memory");
            f32x4 gv[2][2];
#pragma unroll
            for (int bj = 0; bj < 2; ++bj) { gv[bj][0] = *(const f32x4*)(gain + col0f + bj * HALF); gv[bj][1] = *(const f32x4*)(gain + col0f + bj * HALF + 4); }
#pragma unroll
            for (int ai = 0; ai < 2; ++ai)
#pragma unroll
                for (int m = 0; m < 4; ++m) { const int row = row0f + ai * HALF + m * 16; const size_t off = (size_t)row * ldc + col0f;
                    const float* xp = xs + (size_t)row * 16 + 4 * fq;
                    float s = (__hip_atomic_load(xp, __ATOMIC_RELAXED, __HIP_MEMORY_SCOPE_AGENT) + __hip_atomic_load(xp + 1, __ATOMIC_RELAXED, __HIP_MEMORY_SCOPE_AGENT))
                            + (__hip_atomic_load(xp + 2, __ATOMIC_RELAXED, __HIP_MEMORY_SCOPE_AGENT) + __hip_atomic_load(xp + 3, __ATOMIC_RELAXED, __HIP_MEMORY_SCOPE_AGENT));
                    s += __shfl_xor(s, 16); s += __shfl_xor(s, 32);
                    const float rs = __builtin_amdgcn_rsqf(s * (1.0f / 1024.0f) + RMS_EPS);
#pragma unroll
                    for (int bj = 0; bj < 2; ++bj) { *(f32x4*)(out + off + bj * HALF) = acc[ai][bj][m][0] * rs * gv[bj][0]; *(f32x4*)(out + off + bj * HALF + 4) = acc[ai][bj][m][1] * rs * gv[bj][1]; } }
            return;
        }
        const int row0 = u.pm * BM + wr * 64 + fr, col0 = u.pn * BM + wc * 32 + 8 * fq;
#pragma unroll
        for (int ai = 0; ai < 2; ++ai)
#pragma unroll
            for (int m = 0; m < 4; ++m) { const int row = row0 + ai * HALF + m * 16; const size_t off = (size_t)row * ldc + col0; float q = 0.f;
#pragma unroll
                for (int bj = 0; bj < 2; ++bj) { const f32x4 o0 = acc[ai][bj][m][0], o1 = acc[ai][bj][m][1];
                    if (OUTF32) { *(f32x4*)(out + off + bj * HALF) = o0; *(f32x4*)(out + off + bj * HALF + 4) = o1; }
                    q += ((o0[0] * o0[0] + o0[1] * o0[1]) + (o0[2] * o0[2] + o0[3] * o0[3])) + ((o1[0] * o1[0] + o1[1] * o1[1]) + (o1[2] * o1[2] + o1[3] * o1[3]));
                    if (OUTBF) { u32x4 w; w.x = cvt_pk_bf16(o0[0], o0[1]); w.y = cvt_pk_bf16(o0[2], o0[3]); w.z = cvt_pk_bf16(o1[0], o1[1]); w.w = cvt_pk_bf16(o1[2], o1[3]); *(u32x4*)(xb + off + bj * HALF) = w; } }
                q += __shfl_xor(q, 16); q += __shfl_xor(q, 32);
                if (fq == 0) ss[(size_t)row * 16 + u.pn * 4 + wc] = q; }
    }
};
struct EpiResidG {
    static constexpr bool PERM = true, AFTER_DRAIN = true, INIT = false, LDSBASE = true;
    __device__ __forceinline__ const char* base_ptr() const { return (const char*)xb; }
    bf16_t* xb; float* ss; float alpha; int ldc; const bf16_t* wgh; const bf16_t* wgl; float* gp; int mrows;
    __device__ __forceinline__ void fused(f32x4 (&acc)[2][2][4][2], const Unit& u, int wr, int wc, int fr, int fq, PG8_LAS unsigned char* lds, int wid, int lane) const {
        const int row0 = u.pm * BM + wr * 64 + fr, col0 = u.pn * BM + wc * 32 + 8 * fq;
        add_resid(acc, 0.5f, lds, wr, wc, fr, fq);
        asm volatile("s_waitcnt lgkmcnt(0)" ::: "memory"); __builtin_amdgcn_s_barrier(); asm volatile("" ::: "memory");
        bf16x8 bh[2], bl[2];
#pragma unroll
        for (int bj = 0; bj < 2; ++bj) { bh[bj] = *(const bf16x8*)(wgh + (size_t)fr * ldc + col0 + bj * HALF); bl[bj] = *(const bf16x8*)(wgl + (size_t)fr * ldc + col0 + bj * HALF); }
        f32x4 gacc[8];
#pragma unroll
        for (int ai = 0; ai < 2; ++ai)
#pragma unroll
            for (int m = 0; m < 4; ++m) { const int row = row0 + ai * HALF + m * 16; const size_t off = (size_t)row * ldc + col0; float q = 0.f; f32x4 ga = (f32x4){0.f, 0.f, 0.f, 0.f};
#pragma unroll
                for (int bj = 0; bj < 2; ++bj) { const f32x4 o0 = acc[ai][bj][m][0], o1 = acc[ai][bj][m][1];
                    q += ((o0[0] * o0[0] + o0[1] * o0[1]) + (o0[2] * o0[2] + o0[3] * o0[3])) + ((o1[0] * o1[0] + o1[1] * o1[1]) + (o1[2] * o1[2] + o1[3] * o1[3]));
                    u32x4 w; w.x = cvt_pk_bf16(o0[0], o0[1]); w.y = cvt_pk_bf16(o0[2], o0[3]); w.z = cvt_pk_bf16(o1[0], o1[1]); w.w = cvt_pk_bf16(o1[2], o1[3]); *(u32x4*)(xb + off + bj * HALF) = w;
                    const bf16x8 af = __builtin_bit_cast(bf16x8, w);
                    ga = __builtin_amdgcn_mfma_f32_16x16x32_bf16(af, bh[bj], ga, 0, 0, 0); ga = __builtin_amdgcn_mfma_f32_16x16x32_bf16(af, bl[bj], ga, 0, 0, 0); }
                q += __shfl_xor(q, 16); q += __shfl_xor(q, 32);
                if (fq == 0) ss[(size_t)row * 16 + u.pn * 4 + wc] = q;
                gacc[ai * 4 + m] = ga; }
        PG8_LAS float* LP = (PG8_LAS float*)lds;
#pragma unroll
        for (int ai = 0; ai < 2; ++ai)
#pragma unroll
            for (int m = 0; m < 4; ++m)
#pragma unroll
                for (int r = 0; r < 4; ++r) LP[(wc * 256 + ai * HALF + wr * 64 + m * 16 + 4 * fq + r) * 16 + fr] = gacc[ai * 4 + m][r];
        asm volatile("s_waitcnt lgkmcnt(0)" ::: "memory"); __builtin_amdgcn_s_barrier(); asm volatile("" ::: "memory");
        { const int t = wid * 64 + lane, lr = t >> 1, g0 = (t & 1) * 8;
          f32x4 s0 = *(const PG8_LAS f32x4*)(LP + lr * 16 + g0), s1 = *(const PG8_LAS f32x4*)(LP + lr * 16 + g0 + 4);
#pragma unroll
          for (int w = 1; w < 4; ++w) { s0 = s0 + *(const PG8_LAS f32x4*)(LP + (w * 256 + lr) * 16 + g0); s1 = s1 + *(const PG8_LAS f32x4*)(LP + (w * 256 + lr) * 16 + g0 + 4); }
          float* dst = gp + ((size_t)u.pn * mrows + (size_t)u.pm * BM + lr) * 16 + g0; *(f32x4*)dst = s0; *(f32x4*)(dst + 4) = s1; }
    }
};
struct EpiProj {
    static constexpr bool PERM = true, AFTER_DRAIN = false, INIT = false, LDSBASE = false;
    bf16_t* P; int ldp; const float* ss; const PG8_LAS float* rt;
    __device__ __forceinline__ void operator()(const f32x4 (&acc)[2][2][4][2], const Unit& u, int wr, int wc, int fr, int fq) const {
        const int row0 = u.pm * BM + wr * 64 + fr, col0 = u.pn * BM + wc * 32 + 8 * fq;
        float rsv[8];
#pragma unroll
        for (int k = 0; k < 8; ++k) rsv[k] = rt[(row0 + (k >> 2) * HALF + (k & 3) * 16) & 255];
#pragma unroll
        for (int ai = 0; ai < 2; ++ai)
#pragma unroll
            for (int m = 0; m < 4; ++m) { const int row = row0 + ai * HALF + m * 16; const float rs = rsv[ai * 4 + m];
#pragma unroll
                for (int bj = 0; bj < 2; ++bj) { const f32x4 v0 = acc[ai][bj][m][0] * rs, v1 = acc[ai][bj][m][1] * rs;
                    u32x4 w; w.x = cvt_pk_bf16(v0[0], v0[1]); w.y = cvt_pk_bf16(v0[2], v0[3]); w.z = cvt_pk_bf16(v1[0], v1[1]); w.w = cvt_pk_bf16(v1[2], v1[3]);
                    *(u32x4*)(P + (size_t)row * ldp + col0 + bj * HALF) = w; } }
    }
};
template <class Epi, class Sched, bool ALIGN_EPI = false, bool SP2 = false>
__device__ __forceinline__ void gemm_phase(PG8_LAS unsigned char* lds, const Gemm g, const Sched& S, const Epi& E) {
    const int tid = threadIdx.x, wid = __builtin_amdgcn_readfirstlane(tid >> 6), lane = tid & 63, wr = wid >> 2, wc = wid & 3, fr = lane & 15, fq = lane >> 4;
    const int K = g.K, nt = K / BK;
    unsigned voffA[2], voffB[2];
#pragma unroll
    for (int i = 0; i < 2; ++i) { int R, C; stage_rc(tid * 16 + i * 8192, R, C); const int Rb = Epi::PERM ? ((R & ~31) + perm32(R & 31)) : R;
        voffA[i] = (unsigned)(R * K + C) * 2u; voffB[i] = (unsigned)(Rb * K + C) * 2u; }
    const size_t kstep = (size_t)(BK * 2);
    const size_t hstep = (size_t)HALF * K * 2;
    const size_t tstep = 2 * hstep;
    const unsigned ldsw = (unsigned)wid * 1024u;
    const int aoff = lds_byte(wr * 64 + fr, fq * 8), boff = lds_byte(wc * 32 + fr, fq * 8);
#define PG8_SA(b, h) (((b) * 2 + (h)) * HTB)
#define PG8_SB(b, h) ((4 + (b) * 2 + (h)) * HTB)
#define PG8_STAGE(bufoff, gbase, voff) do { _Pragma("unroll") for (int _i = 0; _i < 2; ++_i) \
        __builtin_amdgcn_global_load_lds((const unsigned*)((const char*)(gbase) + (voff)[_i]), (PG8_LAS unsigned*)(lds + (bufoff) + ldsw + _i * 8192), 16, 0, 0); } while (0)
#define PG8_STAGE2(bufoff, gbase, v0, v1) do { __builtin_amdgcn_global_load_lds((const unsigned*)((const char*)(gbase) + (v0)), (PG8_LAS unsigned*)(lds + (bufoff) + ldsw), 16, 0, 0); \
        __builtin_amdgcn_global_load_lds((const unsigned*)((const char*)(gbase) + (v1)), (PG8_LAS unsigned*)(lds + (bufoff) + ldsw + 8192), 16, 0, 0); } while (0)
#define PG8_LDA(dst, b, h) do { _Pragma("unroll") for (int m = 0; m < 4; ++m) _Pragma("unroll") for (int k = 0; k < 2; ++k) dst[m][k] = *(const PG8_LAS bf16x8*)(lds + PG8_SA(b, h) + aoff + m * 2048 + k * 1024); } while (0)
#define PG8_LDB(dst, b, h) do { _Pragma("unroll") for (int n = 0; n < 2; ++n) _Pragma("unroll") for (int k = 0; k < 2; ++k) dst[n][k] = *(const PG8_LAS bf16x8*)(lds + PG8_SB(b, h) + boff + n * 2048 + k * 1024); } while (0)
#define PG8_MMA(ai, bj, At, Bt) do { __builtin_amdgcn_s_setprio(3); _Pragma("unroll") for (int m = 0; m < 4; ++m) _Pragma("unroll") for (int n = 0; n < 2; ++n) _Pragma("unroll") for (int k = 0; k < 2; ++k) \
        acc[ai][bj][m][n] = __builtin_amdgcn_mfma_f32_16x16x32_bf16(Bt[n][k], At[m][k], acc[ai][bj][m][n], 0, 0, 0); __builtin_amdgcn_s_setprio(0); } while (0)
#define PG8_WAIT_V(n) asm volatile("s_waitcnt vmcnt(" #n ")" ::: "memory")
#define PG8_WAIT_L(n) asm volatile("s_waitcnt lgkmcnt(" #n ")" ::: "memory")
#define PG8_BAR __builtin_amdgcn_s_barrier()
#define PG8_SCHED __builtin_amdgcn_sched_barrier(0)
    int ldx = 0; const char* xb0 = nullptr; if constexpr (Epi::LDSBASE) { ldx = E.ldc; xb0 = E.base_ptr(); }
    Unit cur, nxt; int ui = 0;
    if (!S.next(0, cur)) return;
    f32x4 acc[2][2][4][2];
    if constexpr (Epi::INIT) E.init(acc, cur, wr, wc, fr, fq);
    else {
#pragma unroll
    for (int a = 0; a < 2; ++a)
#pragma unroll
        for (int b = 0; b < 2; ++b)
#pragma unroll
            for (int m = 0; m < 4; ++m)
#pragma unroll
                for (int n = 0; n < 2; ++n) acc[a][b][m][n] = (f32x4){0.f, 0.f, 0.f, 0.f};
    }
    bf16x8 At[4][2], B0[2][2], B1[2][2];
    const char* cA = (const char*)g.A + (size_t)cur.pm * tstep; const char* cB = (const char*)g.Bt + (size_t)cur.pn * tstep;
    S.a_ready(cur);
    if constexpr (SP2) {
        PG8_STAGE(PG8_SB(0, 0), cB, voffB); PG8_STAGE(PG8_SB(0, 1), cB + hstep, voffB); PG8_STAGE(PG8_SA(0, 0), cA, voffA); PG8_STAGE(PG8_SA(0, 1), cA + hstep, voffA);
        if (wr == 1) PG8_BAR;
        PG8_WAIT_V(2); PG8_BAR;
        PG8_STAGE(PG8_SB(1, 0), cB + kstep, voffB); PG8_STAGE(PG8_SB(1, 1), cB + hstep + kstep, voffB);
        PG8_WAIT_V(6); PG8_BAR;
    } else {
        PG8_STAGE(PG8_SB(0, 0), cB, voffB); PG8_STAGE(PG8_SA(0, 0), cA, voffA); PG8_STAGE(PG8_SB(0, 1), cB + hstep, voffB); PG8_STAGE(PG8_SA(0, 1), cA + hstep, voffA);
        if (wr == 1) PG8_BAR;
        PG8_WAIT_V(4); PG8_BAR;
        PG8_STAGE(PG8_SB(1, 0), cB + kstep, voffB); PG8_STAGE(PG8_SA(1, 0), cA + kstep, voffA); PG8_STAGE(PG8_SB(1, 1), cB + hstep + kstep, voffB);
        PG8_WAIT_V(6); PG8_BAR;
    }
    for (;;) {
        const bool has_next = S.next(ui + 1, nxt);
        const char* nA = has_next ? (const char*)g.A + (size_t)nxt.pm * tstep : cA; const char* nB = has_next ? (const char*)g.Bt + (size_t)nxt.pn * tstep : cB;
        for (int t = 0; t < nt; t += 2) {
            const bool last = (t == nt - 2);
            const char* a1 = cA + (size_t)(t + 1) * kstep;
            const char* a2 = last ? nA : cA + (size_t)(t + 2) * kstep; const char* b2 = last ? nB : cB + (size_t)(t + 2) * kstep;
            const char* a3 = a2 + kstep; const char* b3 = b2 + kstep;
            if (last && has_next) S.a_ready(nxt);
            const bool lb = Epi::LDSBASE && last && !has_next;
            unsigned vX0 = 0, vX1 = 0; const char* xt = cA; size_t rh = 0;
            if constexpr (Epi::LDSBASE) { if (lb) { int R, C; stage_rc(tid * 16, R, C); vX0 = (unsigned)(R * ldx + C) * 2u; stage_rc(tid * 16 + 8192, R, C); vX1 = (unsigned)(R * ldx + C) * 2u;
                xt = xb0 + ((size_t)cur.pm * BM * ldx + (size_t)cur.pn * BM) * 2; rh = (size_t)HALF * ldx * 2; } }
            if constexpr (SP2) {
            PG8_LDB(B0, 0, 0); PG8_LDB(B1, 0, 1); PG8_SCHED; PG8_LDA(At, 0, 0); PG8_STAGE(PG8_SA(1, 0), a1, voffA); PG8_STAGE(PG8_SA(1, 1), a1 + hstep, voffA);
            PG8_WAIT_V(8); PG8_WAIT_L(0); PG8_BAR; PG8_MMA(0, 0, At, B0); PG8_MMA(0, 1, At, B1); PG8_BAR; PG8_SCHED;
            PG8_LDA(At, 0, 1);
            if (lb) { PG8_STAGE2(PG8_SB(0, 0), xt, vX0, vX1); PG8_STAGE2(PG8_SB(0, 1), xt + 128, vX0, vX1); } else { PG8_STAGE(PG8_SB(0, 0), b2, voffB); PG8_STAGE(PG8_SB(0, 1), b2 + hstep, voffB); }
            PG8_WAIT_V(6); PG8_WAIT_L(0); PG8_BAR; PG8_MMA(1, 0, At, B0); PG8_MMA(1, 1, At, B1); PG8_BAR; PG8_SCHED;
            PG8_LDB(B0, 1, 0); PG8_LDB(B1, 1, 1); PG8_SCHED; PG8_LDA(At, 1, 0);
            if (lb) { PG8_STAGE2(PG8_SA(0, 0), xt + 256, vX0, vX1); PG8_STAGE2(PG8_SA(0, 1), xt + 384, vX0, vX1); PG8_STAGE2(8 * HTB, xt + rh + 384, vX0, vX1); PG8_WAIT_V(10); }
            else { PG8_STAGE(PG8_SA(0, 0), a2, voffA); PG8_STAGE(PG8_SA(0, 1), a2 + hstep, voffA); PG8_WAIT_V(8); }
            PG8_WAIT_L(0); PG8_BAR; PG8_MMA(0, 0, At, B0); PG8_MMA(0, 1, At, B1); PG8_BAR; PG8_SCHED;
            PG8_LDA(At, 1, 1);
            if (lb) { PG8_STAGE2(PG8_SB(1, 0), xt + rh, vX0, vX1); PG8_STAGE2(PG8_SB(1, 1), xt + rh + 128, vX0, vX1); PG8_STAGE2(PG8_SA(1, 0), xt + rh + 256, vX0, vX1); }
            else { PG8_STAGE(PG8_SB(1, 0), b3, voffB); PG8_STAGE(PG8_SB(1, 1), b3 + hstep, voffB); PG8_WAIT_V(6); }
            PG8_WAIT_L(0); PG8_BAR; PG8_MMA(1, 0, At, B0); PG8_MMA(1, 1, At, B1); PG8_BAR; PG8_SCHED;
            } else {
            PG8_LDB(B0, 0, 0); PG8_SCHED; PG8_LDA(At, 0, 0); PG8_STAGE(PG8_SA(1, 1), a1 + hstep, voffA);
            PG8_WAIT_L(8); PG8_BAR; PG8_WAIT_L(0); PG8_MMA(0, 0, At, B0); PG8_BAR; PG8_SCHED;
            PG8_LDB(B1, 0, 1); PG8_STAGE(PG8_SB(0, 0), b2, voffB);
            PG8_BAR; PG8_WAIT_L(0); PG8_MMA(0, 1, At, B1); PG8_BAR;
            PG8_LDA(At, 0, 1); PG8_STAGE(PG8_SA(0, 0), a2, voffA);
            PG8_BAR; PG8_WAIT_L(0); PG8_MMA(1, 0, At, B0); PG8_BAR; PG8_SCHED;
            PG8_STAGE(PG8_SB(0, 1), b2 + hstep, voffB);
            PG8_WAIT_V(6); PG8_BAR; PG8_MMA(1, 1, At, B1); PG8_BAR;
            PG8_LDB(B0, 1, 0); PG8_SCHED; PG8_LDA(At, 1, 0); PG8_STAGE(PG8_SA(0, 1), a2 + hstep, voffA);
            PG8_WAIT_L(8); PG8_BAR; PG8_WAIT_L(0); PG8_MMA(0, 0, At, B0); PG8_BAR; PG8_SCHED;
            PG8_LDB(B1, 1, 1); PG8_STAGE(PG8_SB(1, 0), b3, voffB);
            PG8_BAR; PG8_WAIT_L(0); PG8_MMA(0, 1, At, B1); PG8_BAR;
            PG8_LDA(At, 1, 1); PG8_STAGE(PG8_SA(1, 0), a3, voffA);
            PG8_BAR; PG8_WAIT_L(0); PG8_MMA(1, 0, At, B0); PG8_BAR; PG8_SCHED;
            PG8_STAGE(PG8_SB(1, 1), b3 + hstep, voffB);
            PG8_WAIT_V(6); PG8_BAR; PG8_MMA(1, 1, At, B1); PG8_BAR;
            }
        }
        if constexpr (ALIGN_EPI) { if (wr == 0) PG8_BAR; }
        if constexpr (!Epi::AFTER_DRAIN) { E(acc, cur, wr, wc, fr, fq); S.done(cur); }
        if (!has_next) break;
        if constexpr (Epi::INIT) E.init(acc, nxt, wr, wc, fr, fq);
        else {
#pragma unroll
        for (int a = 0; a < 2; ++a)
#pragma unroll
            for (int b = 0; b < 2; ++b)
#pragma unroll
                for (int m = 0; m < 4; ++m)
#pragma unroll
                    for (int n = 0; n < 2; ++n) acc[a][b][m][n] = (f32x4){0.f, 0.f, 0.f, 0.f};
        }
        cur = nxt; cA = nA; cB = nB; ++ui;
        if constexpr (ALIGN_EPI) { if (wr == 1) PG8_BAR; }
    }
    PG8_WAIT_V(0);
    if constexpr (!ALIGN_EPI) { if (wr == 0) PG8_BAR; }
    PG8_BAR;
    if constexpr (Epi::AFTER_DRAIN) { E.fused(acc, cur, wr, wc, fr, fq, lds, wid, lane); S.done(cur); }
#undef PG8_SA
#undef PG8_SB
#undef PG8_STAGE
#undef PG8_STAGE2
#undef PG8_LDA
#undef PG8_LDB
#undef PG8_MMA
#undef PG8_WAIT_V
#undef PG8_WAIT_L
#undef PG8_BAR
#undef PG8_SCHED
}
}
#define GAS __attribute__((address_space(1)))
#define LAS __attribute__((address_space(3)))
typedef unsigned short bf16;
typedef unsigned v4u __attribute__((ext_vector_type(4)));
typedef float f32x4 __attribute__((ext_vector_type(4)));
typedef short bf16x8 __attribute__((ext_vector_type(8)));
typedef GAS unsigned gu32;
typedef GAS unsigned long long gu64;
#define RLX_AGENT __ATOMIC_RELAXED, __HIP_MEMORY_SCOPE_AGENT
#define LDS_WAIT() asm volatile("s_waitcnt lgkmcnt(0)" ::: "memory")
#define VM_WAIT() asm volatile("s_waitcnt vmcnt(0)" ::: "memory")
__device__ __forceinline__ unsigned long long rt() { return __builtin_amdgcn_s_memrealtime(); }
__device__ __forceinline__ unsigned f2bf(float f) { unsigned u = __builtin_bit_cast(unsigned, f); return (u + 0x7fffu + ((u >> 16) & 1u)) >> 16; }
__device__ __forceinline__ unsigned pk2(float lo, float hi) { return f2bf(lo) | (f2bf(hi) << 16); }
#define XB_TMO      128
#define XB_XCNT(j)  (256  + 64 * (j))
#define XB_XSUB(j)  (1280 + 64 * (j))
#define XB_XGEN(j)  (2304 + 64 * (j))
#define XB_TOP      3328
#define XB_TOPGEN   3392
#define XCD_BAR_WORDS 3456
#define XB_SPIN_CAP (1u << 18)

__device__ __forceinline__ unsigned xb_ld(unsigned* p)              { return __hip_atomic_load(p, __ATOMIC_RELAXED, __HIP_MEMORY_SCOPE_AGENT); }
__device__ __forceinline__ unsigned xb_add(unsigned* p, unsigned v) { return __hip_atomic_fetch_add(p, v, __ATOMIC_RELAXED, __HIP_MEMORY_SCOPE_AGENT); }
__device__ __forceinline__ unsigned xb_xcc_id() { return (unsigned)__builtin_amdgcn_s_getreg((3 << 11) | 20) & 0xFu; }
#define XB_SPIN(cond, bar) do { unsigned _sp = 0; while (cond) { __builtin_amdgcn_s_sleep(1); \
    if ((++_sp & 255u) == 0u) { if (xb_ld(&(bar)[XB_TMO])) break; if (_sp > XB_SPIN_CAP) { atomicAdd(&(bar)[XB_TMO], 1u); break; } } } } while (0)

struct XcdBarrier {
    unsigned* bar; unsigned x;
    volatile LAS unsigned* st;
};

__device__ __forceinline__ XcdBarrier xcd_barrier_post(unsigned* bar, volatile LAS unsigned* st) {
    XcdBarrier b; b.bar = bar; b.x = xb_xcc_id(); b.st = st;
    if (threadIdx.x == 0) (void)xb_add(&bar[XB_XCNT(b.x)], 1u);
    return b;
}
__device__ __forceinline__ void xcd_barrier_complete(unsigned* bar, unsigned x, unsigned& nloc, unsigned& nx) {
    const unsigned G = gridDim.x * gridDim.y * gridDim.z;
    unsigned sum, cnt, mine, sp = 0u;
    for (;;) {
        sum = 0u; cnt = 0u; mine = 0u;
#pragma unroll
        for (unsigned j = 0; j < 16; ++j) { const unsigned c = xb_ld(&bar[XB_XCNT(j)]); sum += c; cnt += (c > 0u) ? 1u : 0u; mine = (j == x) ? c : mine; }
        if (sum == G) break;
        __builtin_amdgcn_s_sleep(1);
        if ((++sp & 255u) == 0u) { if (xb_ld(&bar[XB_TMO])) break; if (sp > XB_SPIN_CAP) { atomicAdd(&bar[XB_TMO], 1u); break; } }
    }
    nloc = mine > 0u ? mine : 1u; nx = cnt > 0u ? cnt : 1u;
}

__device__ __forceinline__ void xcd_barrier(const XcdBarrier& b) {
    asm volatile("s_waitcnt vmcnt(0)" ::: "memory");
    __syncthreads();
    if (threadIdx.x == 0) {
        unsigned* bar = b.bar;
        __builtin_amdgcn_s_waitcnt(0);
        unsigned nloc = b.st[0], nx = b.st[1];
        if (nloc == 0u) { xcd_barrier_complete(bar, b.x, nloc, nx); b.st[0] = nloc; b.st[1] = nx; }
        const unsigned old = xb_add(&bar[XB_XSUB(b.x)], 1u);
        const unsigned gen = old / nloc;
        if (old + 1u == (gen + 1u) * nloc) {
            __builtin_amdgcn_fence(__ATOMIC_RELEASE, "agent");
            asm volatile("s_waitcnt vmcnt(0)" ::: "memory");
            const unsigned og = xb_add(&bar[XB_TOP], 1u);
            const unsigned tg = og / nx;
            if (og + 1u == (tg + 1u) * nx) xb_add(&bar[XB_TOPGEN], 1u);
            else XB_SPIN(xb_ld(&bar[XB_TOPGEN]) == tg, bar);
            __builtin_amdgcn_fence(__ATOMIC_ACQUIRE, "agent");
            xb_add(&bar[XB_XGEN(b.x)], 1u);
            asm volatile("s_waitcnt vmcnt(0)" ::: "memory");
        } else {
            XB_SPIN(xb_ld(&bar[XB_XGEN(b.x)]) == gen, bar);
            __builtin_amdgcn_fence(__ATOMIC_ACQUIRE, "agent");
            asm volatile("s_waitcnt vmcnt(0)" ::: "memory");
        }
    }
    __syncthreads();
}

constexpr int NWAVES = 8;
constexpr int BATCH = 2, T = 8192, D = 1024, M = BATCH * T, FF = 2816, NFF2 = 2 * FF;
constexpr int MLH = 4, MLD = 128, MLW = 512, NAH = 8, NAD = 64, NG = 16, DIN = 3088, NPROJ = 3072;
constexpr int GW = 64, GROWS = T / GW;
constexpr int PC_C = 0, PC_V = 512, PC_O = 1024, PC_QN = 1536, PC_KN = 2048, PC_VN = 2560;
constexpr float EPS = 1e-6f;

constexpr size_t MiB = 1u << 20;
constexpr size_t WS_CTL = 0, CTL_ZERO_BYTES = 1 * MiB;
constexpr size_t WS_W1T = 2 * MiB;
constexpr size_t WS_W1DT = 13 * MiB;
constexpr size_t WS_WINT = 19 * MiB;
constexpr size_t WS_WOUTT = 25 * MiB;
constexpr size_t WS_W2T = 27 * MiB;
constexpr size_t WS_W2DT = 38 * MiB;
constexpr size_t WS_WQT = 44 * MiB;
constexpr size_t WS_WG = 45 * MiB;
constexpr size_t WS_SS = 46 * MiB;
constexpr size_t WS_GATES = 246 * MiB;
constexpr size_t WS_XS = 49 * MiB;
constexpr size_t WS_XB = 50 * MiB;
constexpr size_t WS_HP = 82 * MiB;
constexpr size_t WS_Y = 178 * MiB;
constexpr size_t WS_CHS = 48 * MiB;
constexpr size_t WS_M0 = 48 * MiB + 65536;
constexpr size_t WS_CL = 210 * MiB;
constexpr size_t WS_END = 256 * MiB;
constexpr int CW_TMO = 0, CW_CODE = 1, CW_BAR = 4096, CW_PAN = 8192;

constexpr int RING_OFF = 0, RING_BYTES = 131072;
constexpr int LDS_BYTES = 163840;
constexpr int LDSCTL_OFF = LDS_BYTES - 512, MISC_OFF = LDSCTL_OFF + 320;

__device__ __forceinline__ float wave_sum(float v) {
#pragma unroll
    for (int o = 1; o < 64; o <<= 1) v += __shfl_xor(v, o);
    return v;
}
__device__ __forceinline__ float wave_max(float v) {
#pragma unroll
    for (int o = 1; o < 64; o <<= 1) v = fmaxf(v, __shfl_xor(v, o));
    return v;
}
__device__ __forceinline__ float bf2f(bf16 v) { return __builtin_bit_cast(float, (unsigned)v << 16); }

__device__ __forceinline__ void transpose_item(const float* W, int ldw, int k0, int nsrc0, const float* gain, bf16* WT, int K, int dstrow0, LAS float* scr, int lane, float scale = 1.0f) {
    float tv[32];
#pragma unroll
    for (int i = 0; i < 32; ++i) tv[i] = __builtin_nontemporal_load(W + (size_t)(k0 + 2 * i + (lane >> 5)) * ldw + nsrc0 + (lane & 31));
#pragma unroll
    for (int i = 0; i < 32; ++i) { const int kk = 2 * i + (lane >> 5); float v = tv[i]; if (gain) v *= gain[k0 + kk]; scr[kk * 33 + (lane & 31)] = v * scale; }
    LDS_WAIT(); asm volatile("" ::: "memory");
    const int c = lane & 7;
#pragma unroll
    for (int j = 0; j < 4; ++j) { const int n = (lane >> 3) + 8 * j; const LAS float* s = scr + (8 * c) * 33 + n;
        v4u o; o.x = pk2(s[0 * 33], s[1 * 33]); o.y = pk2(s[2 * 33], s[3 * 33]); o.z = pk2(s[4 * 33], s[5 * 33]); o.w = pk2(s[6 * 33], s[7 * 33]);
        *(GAS v4u*)(WT + (size_t)(dstrow0 + n) * K + k0 + 8 * c) = o; }
    LDS_WAIT(); asm volatile("" ::: "memory");
}

__device__ __forceinline__ void transpose_item_wide_load(f32x4 (&tv)[16], const float* W, int ldw, int k0, int nsrc0, int lane) {
#pragma unroll
    for (int i = 0; i < 16; ++i) tv[i] = __builtin_nontemporal_load((const GAS f32x4*)(W + (size_t)(k0 + 2 * i + (lane >> 5)) * ldw + nsrc0 + 4 * (lane & 31)));
}
__device__ __forceinline__ void transpose_item_wide_finish(const f32x4 (&tv)[16], int k0, const float* gain, bf16* WT, int K, int dstrow0, LAS float* scr, int lane) {
    constexpr int PITCH = 132;
#pragma unroll
    for (int i = 0; i < 16; ++i) { const int kk = 2 * i + (lane >> 5); const float gs = gain ? gain[k0 + kk] : 1.0f; *(LAS f32x4*)(scr + kk * PITCH + 4 * (lane & 31)) = tv[i] * gs; }
    LDS_WAIT(); asm volatile("" ::: "memory");
#pragma unroll
    for (int r = 0; r < 8; ++r) { const int idx = lane + 64 * r, n = idx >> 2, c = idx & 3; const LAS float* s = scr + (8 * c) * PITCH + n;
        v4u o; o.x = pk2(s[0 * PITCH], s[1 * PITCH]); o.y = pk2(s[2 * PITCH], s[3 * PITCH]); o.z = pk2(s[4 * PITCH], s[5 * PITCH]); o.w = pk2(s[6 * PITCH], s[7 * PITCH]);
        *(GAS v4u*)(WT + (size_t)(dstrow0 + n) * K + k0 + 8 * c) = o; }
    LDS_WAIT(); asm volatile("" ::: "memory");
}
__device__ __forceinline__ void transpose_item_wide(const float* W, int ldw, int k0, int nsrc0, const float* gain, bf16* WT, int K, int dstrow0, LAS float* scr, int lane) {
    f32x4 tv[16]; transpose_item_wide_load(tv, W, ldw, k0, nsrc0, lane); transpose_item_wide_finish(tv, k0, gain, WT, K, dstrow0, scr, lane);
}
struct Ptrs {
    const float *x, *g1, *w1g, *w1u, *w1d, *gm, *win, *bg, *cw, *cb, *wq, *wk, *gn, *gq, *gk, *rpb, *wout, *g2, *w2g, *w2u, *w2d, *gf;
    float* out;
    bf16 *W1T, *W1DT, *WINT, *WOUTT, *W2T, *W2DT, *XB, *QB, *KB, *H, *PROJ, *Y;
    bf16 *WGH, *WGL, *WQT, *WKT; float *SS, *GATES;
};

__device__ __forceinline__ void p0_deferred(const Ptrs& P, LAS unsigned char* lds, int lo, int hi, int dw, int NDW, int lane, int wave) {
    LAS float* scr = (LAS float*)(lds + RING_OFF + wave * 16384);
    constexpr int I_GU = 16 * 88, I_DN = 44 * 32, I_IN = 16 * 96, I_OUT = 16 * 32;
    constexpr int NITEMS = 2 * I_DN + I_IN + I_OUT + 2 * I_GU;
    (void)NITEMS;
    for (int it = lo + dw; it < hi; it += NDW) {
        int r = it;
        if (r < I_DN) { const int kb = r / 32, nb = r % 32; transpose_item(P.w1d, D, 64 * kb, 32 * nb, nullptr, P.W1DT, FF, 32 * nb, scr, lane); continue; }
        r -= I_DN;
        if (r < I_IN) { const int kb = r / 96, nb = r % 96, nd = 32 * nb, ns = nd < 1536 ? nd : nd + 16; transpose_item(P.win, DIN, 64 * kb, ns, P.gm, P.WINT, D, nd, scr, lane); continue; }
        r -= I_IN;
        if (r < I_OUT) { const int kb = r / 32, nb = r % 32; transpose_item(P.wout, D, 64 * kb, 32 * nb, nullptr, P.WOUTT, D, 32 * nb, scr, lane); continue; }
        r -= I_OUT;
        if (r < 2 * I_GU) { const bool up = r >= I_GU; if (up) r -= I_GU; const int kb = r / 88, nb = r % 88, n0 = 32 * nb, dst = 256 * (n0 >> 7) + (n0 & 127) + (up ? 128 : 0);
            transpose_item(up ? P.w2u : P.w2g, FF, 64 * kb, n0, P.g2, P.W2T, D, dst, scr, lane); continue; }
        r -= 2 * I_GU;
        { const int kb = r / 32, nb = r % 32; transpose_item(P.w2d, D, 64 * kb, 32 * nb, nullptr, P.W2DT, FF, 32 * nb, scr, lane); }
    }
}
__device__ __forceinline__ void p0_prologue(const Ptrs& P, LAS unsigned char* lds, int gw, int NGW, int lane, int wave, int gtid, int NGT) {
    LAS float* scr = (LAS float*)(lds + RING_OFF + wave * 17408);
    f32x4 v[8][4];
#define P0_ROWS_LOAD(m0_) do { _Pragma("unroll") for (int r = 0; r < 8; ++r) { const int mm = (NGW == 2048) ? 8 * (m0_) + r : (m0_) + r * NGW;     const GAS f32x4* xr = (const GAS f32x4*)(P.x + (size_t)(mm < M ? mm : (m0_)) * D) + lane; \
        _Pragma("unroll") for (int j = 0; j < 4; ++j) v[r][j] = __builtin_nontemporal_load(xr + 64 * j); } } while (0)
    constexpr int I_GUW = 32 * 22;
    const int it0 = wave * (NGW / NWAVES) + gw / NWAVES;
    { f32x4 tv[16]; int r = it0; const bool has = r < 2 * I_GUW; const bool up = r >= I_GUW; if (up) r -= I_GUW; const int kb = r / 22, nb = r % 22;
      if (has) transpose_item_wide_load(tv, up ? P.w1u : P.w1g, FF, 32 * kb, 128 * nb, lane);
      P0_ROWS_LOAD(gw);
      if (has) transpose_item_wide_finish(tv, 32 * kb, P.g1, P.W1T, D, 256 * nb + (up ? 128 : 0), scr, lane); }
    for (int it = it0 + NGW; it < 2 * I_GUW; it += NGW) { int r = it; const bool up = r >= I_GUW; if (up) r -= I_GUW; const int kb = r / 22, nb = r % 22;
        transpose_item_wide(up ? P.w1u : P.w1g, FF, 32 * kb, 128 * nb, P.g1, P.W1T, D, 256 * nb + (up ? 128 : 0), scr, lane); }
    if (wave == NWAVES - 1) for (int it = gw / NWAVES; it < 64; it += NGW / NWAVES) { const int isk = it >> 5,     hh = (it >> 3) & 3, kb = (it >> 2) & 1, nb = it & 3;
        transpose_item((isk ? P.wk : P.wq) + (size_t)hh * MLD * MLD, MLD, 64 * kb, 32 * nb, nullptr, (isk ? P.WKT : P.WQT) + (size_t)hh * MLD * MLD, MLD, 32 * nb, scr, lane, isk ? 0.08838834764831845f : 1.0f); }
    if (wave == NWAVES - 2) for (int i = (gw / NWAVES) * 64 + lane; i < NG * D; i += (NGW / NWAVES) * 64) { const int j = i >> 10, k = i & 1023;     const float w = P.gm[k] * P.win[(size_t)k * DIN + 1536 + j]; const unsigned h = f2bf(w);
        P.WGH[i] = (bf16)h; P.WGL[i] = (bf16)f2bf(w - __builtin_bit_cast(float, h << 16)); }
    for (int m0_ = gw; m0_ < M; m0_ += 8 * NGW) {
        if (m0_ != gw) P0_ROWS_LOAD(m0_);
        float s[8];
#pragma unroll
        for (int r = 0; r < 8; ++r) { float q = 0.f;
#pragma unroll
            for (int j = 0; j < 4; ++j) q += (v[r][j].x * v[r][j].x + v[r][j].y * v[r][j].y) + (v[r][j].z * v[r][j].z + v[r][j].w * v[r][j].w);
            s[r] = q; }
#pragma unroll
        for (int o = 1; o < 64; o <<= 1) {
#pragma unroll
            for (int r = 0; r < 8; ++r) s[r] += __shfl_xor(s[r], o); }
#pragma unroll
        for (int r = 0; r < 8; ++r) { const int mm = (NGW == 2048) ? 8 * m0_ + r : m0_ + r * NGW; if (mm < M) {
            GAS unsigned long long* o8 = (GAS unsigned long long*)(P.XB + (size_t)mm * D) + lane;
#pragma unroll
            for (int j = 0; j < 4; ++j) o8[64 * j] = (unsigned long long)pk2(v[r][j].x, v[r][j].y) | ((unsigned long long)pk2(v[r][j].z, v[r][j].w) << 32);
            if (lane < 16) P.SS[(size_t)mm * 16 + lane] = lane == 0 ? s[r] : 0.f; } }
    }
#undef P0_ROWS_LOAD
}

__device__ __forceinline__ float logsigmoidf(float x) { return fminf(x, 0.f) - log1pf(__expf(-fabsf(x))); }


constexpr int MLC = 128, NCH = T / MLC, MLP = 144, MLPB = MLP * 2;
constexpr int CL_STATE_BYTES = MLP * MLD * 2;
typedef short v4i16_t __attribute__((ext_vector_type(4)));
typedef float f32x2_t __attribute__((ext_vector_type(2))); typedef __bf16 bf16x2_t __attribute__((ext_vector_type(2)));
__device__ __forceinline__ unsigned cvtpk(float lo, float hi) { f32x2_t v = {lo, hi}; bf16x2_t b = __builtin_convertvector(v, bf16x2_t); return __builtin_bit_cast(unsigned, b); }
__device__ __forceinline__ bf16x8 tr_pair(const LAS unsigned char* p0, const LAS unsigned char* p1) {
    const v4i16_t a = __builtin_amdgcn_ds_read_tr16_b64_v4i16((LAS v4i16_t*)p0), b = __builtin_amdgcn_ds_read_tr16_b64_v4i16((LAS v4i16_t*)p1);
    return (bf16x8){a[0], a[1], a[2], a[3], b[0], b[1], b[2], b[3]};
}
__device__ __forceinline__ float bflo(unsigned w) { return __builtin_bit_cast(float, w << 16); }
__device__ __forceinline__ float bfhi(unsigned w) { return __builtin_bit_cast(float, w & 0xffff0000u); }
__device__ __forceinline__ v4u scale_bf16x8(v4u v, float s) {
    v4u o; o.x = cvtpk(bflo(v.x) * s, bfhi(v.x) * s); o.y = cvtpk(bflo(v.y) * s, bfhi(v.y) * s); o.z = cvtpk(bflo(v.z) * s, bfhi(v.z) * s); o.w = cvtpk(bflo(v.w) * s, bfhi(v.w) * s); return o;
}
__device__ __forceinline__ float wave_incl_sum(float v, int lane) {
#pragma unroll
    for (int o = 1; o < 64; o <<= 1) { const float t = __shfl_up(v, o); if (lane >= o) v += t; }
    return v;
}
__device__ __forceinline__ float wave_incl_max(float v, int lane) {
#pragma unroll
    for (int o = 1; o < 64; o <<= 1) { const float t = __shfl_up(v, o); if (lane >= o) v = fmaxf(v, t); }
    return v;
}
__device__ __forceinline__ void ml_load_gates(const float* GATES, const float* SS, const float* bg, int row0, int hh, LAS float* G4, int tid) {
    if (tid < MLC) { const float* gp = GATES + (size_t)(row0 + tid) * NG + hh; const float rs = pg8::rstd_from_ss(SS, row0 + tid);
        float v[4];
#pragma unroll
        for (int k = 0; k < 4; ++k) v[k] = (gp[4 * k] + gp[(size_t)M * NG + 4 * k]) + (gp[(size_t)2 * M * NG + 4 * k] + gp[(size_t)3 * M * NG + 4 * k]);
        G4[tid] = rs * v[0] + bg[hh]; G4[MLC + tid] = logsigmoidf(rs * v[1] + bg[4 + hh]);
        G4[2 * MLC + tid] = rs * v[2] + bg[8 + hh]; G4[3 * MLC + tid] = logsigmoidf(rs * v[3] + bg[12 + hh]); }
}

__device__ __forceinline__ void mlb_unit(const Ptrs& P, bf16* CL, float* CHS, LAS unsigned char* lds, int unit, int tid, int wave, int lane, const bf16x8 (&aq)[4], const bf16x8 (&ak)[4]) {
    typedef unsigned u32x2v __attribute__((ext_vector_type(2)));
    asm volatile("" : "+v"(tid), "+v"(lane));
    const int c = unit & (NCH - 1), bh = unit / NCH, b = bh >> 2, hh = bh & 3, row0 = b * T + c * MLC;
    LAS unsigned char* KF = lds; LAS unsigned char* KW = lds + MLC * MLPB; LAS unsigned char* VP = lds + 2 * MLC * MLPB;
    LAS float* G4 = (LAS float*)(lds + 3 * MLC * MLPB); LAS float* WF = G4 + 4 * MLC; LAS float* WB = WF + MLC;
    const int i = lane & 15, g = lane >> 4, tq = i >> 2, tp = i & 3;
    const int ch8 = tid & 15, tg = tid >> 4, cbase = hh * MLD + 8 * ch8;
    v4u xin[8]; f32x4 cwv[5][2]; f32x4 cbv0, cbv1;
#pragma unroll
    for (int k = 0; k < 8; ++k) { const int tt = c * MLC + 4 * tg - 2 + k; const int tc = min(max(tt, 0), T - 1);
        xin[k] = *(const GAS v4u*)(P.PROJ + (size_t)(b * T + tc) * NPROJ + PC_C + cbase); }
#pragma unroll
    for (int jj = 0; jj < 5; ++jj) { cwv[jj][0] = *(const GAS f32x4*)(P.cw + jj * MLW + cbase); cwv[jj][1] = *(const GAS f32x4*)(P.cw + jj * MLW + cbase + 4); }
    cbv0 = *(const GAS f32x4*)(P.cb + cbase); cbv1 = *(const GAS f32x4*)(P.cb + cbase + 4);
    v4u vpre[4];
#pragma unroll
    for (int r = 0; r < 4; ++r) { const int q = tid + 512 * r, s = q >> 4, ce = q & 15; vpre[r] = *(const GAS v4u*)(P.PROJ + (size_t)(row0 + s) * NPROJ + PC_V + hh * MLD + 8 * ce); }
    ml_load_gates(P.GATES, P.SS, P.bg, row0, hh, G4, tid);
    __syncthreads();
    if (wave < 2) { const int dir = wave; const LAS float* li = G4 + 2 * dir * MLC; const LAS float* lf = li + MLC;
        const int t0 = dir ? MLC - 1 - 2 * lane : 2 * lane, t1 = dir ? t0 - 1 : t0 + 1;
        const float x0 = lf[t0], x1 = lf[t1]; const float S = wave_incl_sum(x0 + x1, lane); const float f0 = S - x1, f1 = S;
        const float a0 = li[t0] - f0, a1 = li[t1] - f1; const float amax = wave_max(fmaxf(a0, a1));
        LAS float* W = dir ? WB : WF; W[t0] = __expf(a0 - amax); W[t1] = __expf(a1 - amax);
        const float g = __shfl(S, 63);
        if (lane == 0) { float* ch = CHS + ((size_t)(dir * 8 + bh) * NCH + c) * 2; ch[0] = g; ch[1] = g + amax; } }
    { float cbv[8]; cbv[0] = cbv0[0]; cbv[1] = cbv0[1]; cbv[2] = cbv0[2]; cbv[3] = cbv0[3]; cbv[4] = cbv1[0]; cbv[5] = cbv1[1]; cbv[6] = cbv1[2]; cbv[7] = cbv1[3];
      float y[4][8];
#pragma unroll
      for (int tok = 0; tok < 4; ++tok)
#pragma unroll
          for (int e = 0; e < 8; ++e) y[tok][e] = cbv[e];
#pragma unroll
      for (int k = 0; k < 8; ++k) { const int tt = c * MLC + 4 * tg - 2 + k;
          const bool inb = tt >= 0 && tt < T; const v4u v = xin[k];
          float x[8]; x[0] = inb ? bflo(v.x) : 0.f; x[1] = inb ? bfhi(v.x) : 0.f; x[2] = inb ? bflo(v.y) : 0.f; x[3] = inb ? bfhi(v.y) : 0.f;
          x[4] = inb ? bflo(v.z) : 0.f; x[5] = inb ? bfhi(v.z) : 0.f; x[6] = inb ? bflo(v.w) : 0.f; x[7] = inb ? bfhi(v.w) : 0.f;
#pragma unroll
          for (int tok = 0; tok < 4; ++tok) { const int jj = k - tok;
              if (jj >= 0 && jj < 5) { const f32x4 w0 = cwv[jj][0], w1 = cwv[jj][1];
                  y[tok][0] += x[0] * w0[0]; y[tok][1] += x[1] * w0[1]; y[tok][2] += x[2] * w0[2]; y[tok][3] += x[3] * w0[3];
                  y[tok][4] += x[4] * w1[0]; y[tok][5] += x[5] * w1[1]; y[tok][6] += x[6] * w1[2]; y[tok][7] += x[7] * w1[3]; } } }
#pragma unroll
      for (int tok = 0; tok < 4; ++tok) { float u[8];
#pragma unroll
          for (int e = 0; e < 8; ++e) u[e] = y[tok][e] * __builtin_amdgcn_rcpf(1.0f + __builtin_amdgcn_exp2f(y[tok][e] * -1.4426950408889634f));
          v4u o; o.x = cvtpk(u[0], u[1]); o.y = cvtpk(u[2], u[3]); o.z = cvtpk(u[4], u[5]); o.w = cvtpk(u[6], u[7]);
          *(LAS v4u*)(VP + (4 * tg + tok) * MLPB + 16 * ch8) = o; } }
    __syncthreads();
    {
      const bool godd = (g & 1) != 0;
#pragma unroll
      for (int np = 0; np < 4; ++np) { u32x2v wq[2], wk[2];
#pragma unroll
        for (int h2 = 0; h2 < 2; ++h2) { const int nt = 2 * np + h2; f32x4 cq = (f32x4){0.f, 0.f, 0.f, 0.f}, ck = (f32x4){0.f, 0.f, 0.f, 0.f};
#pragma unroll
          for (int ks = 0; ks < 4; ++ks) { const bf16x8 uf = *(const LAS bf16x8*)(VP + (16 * nt + i) * MLPB + 64 * ks + 16 * g);
              cq = __builtin_amdgcn_mfma_f32_16x16x32_bf16(aq[ks], uf, cq, 0, 0, 0); ck = __builtin_amdgcn_mfma_f32_16x16x32_bf16(ak[ks], uf, ck, 0, 0, 0); }
          const int t = 16 * nt + i;
          wq[h2].x = cvtpk(cq[0], cq[1]); wq[h2].y = cvtpk(cq[2], cq[3]); wk[h2].x = cvtpk(ck[0], ck[1]); wk[h2].y = cvtpk(ck[2], ck[3]);
          const float wf = WF[t], wb = WB[t]; u32x2v w;
          w.x = cvtpk(ck[0] * wf, ck[1] * wf); w.y = cvtpk(ck[2] * wf, ck[3] * wf); *(LAS u32x2v*)(KF + t * MLPB + 32 * wave + 8 * g) = w;
          w.x = cvtpk(ck[0] * wb, ck[1] * wb); w.y = cvtpk(ck[2] * wb, ck[3] * wb); *(LAS u32x2v*)(KW + t * MLPB + 32 * wave + 8 * g) = w; }
        const unsigned rqx = __shfl_xor(godd ? wq[0].x : wq[1].x, 16), rqy = __shfl_xor(godd ? wq[0].y : wq[1].y, 16), rkx = __shfl_xor(godd ? wk[0].x : wk[1].x, 16), rky = __shfl_xor(godd ? wk[0].y : wk[1].y, 16);
        v4u oq, ok; if (godd) { oq.x = rqx; oq.y = rqy; oq.z = wq[1].x; oq.w = wq[1].y; ok.x = rkx; ok.y = rky; ok.z = wk[1].x; ok.w = wk[1].y; }
        else { oq.x = wq[0].x; oq.y = wq[0].y; oq.z = rqx; oq.w = rqy; ok.x = wk[0].x; ok.y = wk[0].y; ok.z = rkx; ok.w = rky; }
        const size_t go = (size_t)(row0 + 16 * (2 * np + (godd ? 1 : 0)) + i) * MLW + hh * MLD + 16 * wave + 4 * (g & ~1);
        *(GAS v4u*)(P.QB + go) = oq; *(GAS v4u*)(P.KB + go) = ok; } }
    __syncthreads();
#pragma unroll
    for (int r = 0; r < 4; ++r) { const int q = tid + 512 * r, s = q >> 4, ce = q & 15;
        *(LAS v4u*)(VP + s * MLPB + 16 * ce) = vpre[r]; }
    if (tid < MLC) { *(LAS v4u*)(VP + tid * MLPB + 256) = (v4u){0x00003F80u, 0u, 0u, 0u}; *(LAS v4u*)(VP + tid * MLPB + 272) = (v4u){0u, 0u, 0u, 0u}; }
    __syncthreads();
    f32x4 acc[2][9];
#pragma unroll
    for (int d = 0; d < 2; ++d)
#pragma unroll
        for (int n = 0; n < 9; ++n) acc[d][n] = (f32x4){0.f, 0.f, 0.f, 0.f};
    const int troff = (4 * g + tq) * MLPB + 8 * tp;
#pragma unroll
    for (int kk = 0; kk < 4; ++kk) {
        const int so = troff + 32 * kk * MLPB;
        const bf16x8 af = tr_pair(KF + so + 32 * wave, KF + so + 16 * MLPB + 32 * wave), ab = tr_pair(KW + so + 32 * wave, KW + so + 16 * MLPB + 32 * wave);
#pragma unroll
        for (int n = 0; n < 9; ++n) { const bf16x8 bv = tr_pair(VP + so + 32 * n, VP + so + 16 * MLPB + 32 * n);
            acc[0][n] = __builtin_amdgcn_mfma_f32_16x16x32_bf16(af, bv, acc[0][n], 0, 0, 0); acc[1][n] = __builtin_amdgcn_mfma_f32_16x16x32_bf16(ab, bv, acc[1][n], 0, 0, 0); }
    }
#pragma unroll
    for (int d = 0; d < 2; ++d) { bf16* st = CL + ((size_t)(d * 8 + bh) * NCH + c) * (MLP * MLD);
#pragma unroll
        for (int n2 = 0; n2 < 4; ++n2) { const f32x4 v0 = acc[d][2 * n2], v1 = acc[d][2 * n2 + 1]; const bool godd = (g & 1) != 0;
            const unsigned a0 = cvtpk(v0[0], v0[1]), a1 = cvtpk(v0[2], v0[3]), b0 = cvtpk(v1[0], v1[1]), b1 = cvtpk(v1[2], v1[3]);
            const unsigned rx = __shfl_xor(godd ? a0 : b0, 16), ry = __shfl_xor(godd ? a1 : b1, 16);
            v4u o; if (godd) { o.x = rx; o.y = ry; o.z = b0; o.w = b1; } else { o.x = a0; o.y = a1; o.z = rx; o.w = ry; }
            *(GAS v4u*)(st + (size_t)(16 * (2 * n2 + (godd ? 1 : 0)) + i) * MLD + 16 * wave + 4 * (g & ~1)) = o; }
        { const f32x4 v = acc[d][8]; typedef unsigned u32x2v __attribute__((ext_vector_type(2))); u32x2v w; w.x = cvtpk(v[0], v[1]); w.y = cvtpk(v[2], v[3]);
            *(GAS u32x2v*)(st + (size_t)(16 * 8 + i) * MLD + 16 * wave + 4 * g) = w; } }
    __syncthreads();
}

__device__ __forceinline__ void ml_scan(bf16* CL, const float* CHS, float* M0, LAS unsigned char* lds, int blk, int tid) {
    typedef unsigned u32x2v __attribute__((ext_vector_type(2)));
    const int combo = blk >> 3, slice = blk & 7, dir = combo >> 3;
    LAS float* AL = (LAS float*)lds; LAS float* BE = AL + NCH;
    LAS float* GS = BE + NCH; LAS float* MLS = GS + NCH;
    LAS float* OS = MLS + NCH;
    unsigned char* base = (unsigned char*)CL + (size_t)combo * NCH * CL_STATE_BYTES + (size_t)slice * 4608 + (size_t)tid * 8;
    const bool w0 = tid < 64;
    float g = 0.f, ml = 0.f;
    if (tid < NCH) { const int c = dir ? NCH - 1 - tid : tid; g = CHS[((size_t)combo * NCH + c) * 2]; ml = CHS[((size_t)combo * NCH + c) * 2 + 1]; }
    u32x2v v[16], w[16];
#define SCAN_LOAD(it0_) do { _Pragma("unroll") for (int k = 0; k < 16; ++k) { const int c = dir ? NCH - 1 - ((it0_) + k) : (it0_) + k; v[k] = __builtin_nontemporal_load((const GAS u32x2v*)(base + (size_t)c * CL_STATE_BYTES)); } \
        if (w0) { _Pragma("unroll") for (int k = 0; k < 16; ++k) { const int c = dir ? NCH - 1 - ((it0_) + k) : (it0_) + k; w[k] = *(const GAS u32x2v*)(base + 4096 + (size_t)c * CL_STATE_BYTES); } } } while (0)
    SCAN_LOAD(0);
    if (tid < NCH) { const int c = dir ? NCH - 1 - tid : tid;
        float a = g, b = ml;
#pragma unroll
        for (int off = 1; off < 64; off <<= 1) { const float ap = __shfl_up(a, off), bp = __shfl_up(b, off); if (tid >= off) { b = fmaxf(bp + a, b); a = ap + a; } }
        const float mafter = fmaxf(a, b), mprev = __shfl_up(mafter, 1), m0 = tid == 0 ? 0.f : mprev;
        const float cp = fmaxf(m0, ml - g);
        if (slice == 0) M0[combo * NCH + c] = cp;
        OS[tid] = __expf(m0 - cp);
        const float mn = fmaxf(g + m0, ml); AL[tid] = __expf(g + m0 - mn); BE[tid] = __expf(ml - mn); }
    __syncthreads();
    float s0 = 0.f, s1 = 0.f, s2 = 0.f, s3 = 0.f, t0 = 0.f, t1 = 0.f, t2 = 0.f, t3 = 0.f;
#pragma unroll 1
    for (int it0 = 0; it0 < NCH; it0 += 16) {
        if (it0) SCAN_LOAD(it0);
#pragma unroll
        for (int k = 0; k < 16; ++k) { const int c = dir ? NCH - 1 - (it0 + k) : it0 + k; const float os = OS[it0 + k]; u32x2v o; o.x = cvtpk(s0 * os, s1 * os); o.y = cvtpk(s2 * os, s3 * os);
            *(GAS u32x2v*)(base + (size_t)c * CL_STATE_BYTES) = o;
            const float al = AL[it0 + k], be = BE[it0 + k];
            s0 = al * s0 + be * bflo(v[k].x); s1 = al * s1 + be * bfhi(v[k].x); s2 = al * s2 + be * bflo(v[k].y); s3 = al * s3 + be * bfhi(v[k].y);
            if (w0) { u32x2v o2; o2.x = cvtpk(t0 * os, t1 * os); o2.y = cvtpk(t2 * os, t3 * os); *(GAS u32x2v*)(base + 4096 + (size_t)c * CL_STATE_BYTES) = o2;
                t0 = al * t0 + be * bflo(w[k].x); t1 = al * t1 + be * bfhi(w[k].x); t2 = al * t2 + be * bflo(w[k].y); t3 = al * t3 + be * bfhi(w[k].y); } }
    }
#undef SCAN_LOAD
    __syncthreads();
}

__device__ __forceinline__ void mld_unit(const Ptrs& P, const bf16* CL, const float* M0, LAS unsigned char* lds, int unit, int tid, int wave, int lane, const f32x4 (&gnw)[8]) {
    asm volatile("" : "+v"(tid), "+v"(lane));
    typedef unsigned u32x2v __attribute__((ext_vector_type(2)));
    const int c = unit & (NCH - 1), bh = unit / NCH, b = bh >> 2, hh = bh & 3, row0 = b * T + c * MLC;
    LAS unsigned char* KS = lds; LAS unsigned char* VP = lds + MLC * MLPB; LAS unsigned char* ST = lds + 2 * MLC * MLPB;
    LAS float* G4 = (LAS float*)(lds + 2 * MLC * MLPB + 2 * MLP * MLPB);
    LAS float* AF = G4 + 4 * MLC; LAS float* MXA = AF + 2 * MLC; LAS float* CLA = MXA + 2 * MLC;
    const int i = lane & 15, g = lane >> 4, tq = i >> 2, tp = i & 3;
    const int tl = 16 * wave + i;
    v4u kk_[4], vv_[4], sv[2][5], qf[4];
#pragma unroll
    for (int r = 0; r < 4; ++r) { const int q = tid + 512 * r, s = q >> 4, ce = q & 15;
        kk_[r] = __builtin_nontemporal_load((const GAS v4u*)(P.KB + (size_t)(row0 + s) * MLW + hh * MLD + 8 * ce)); vv_[r] = __builtin_nontemporal_load((const GAS v4u*)(P.PROJ + (size_t)(row0 + s) * NPROJ + PC_V + hh * MLD + 8 * ce)); }
#pragma unroll
    for (int dir = 0; dir < 2; ++dir) { const bf16* st = CL + ((size_t)(dir * 8 + bh) * NCH + c) * (MLP * MLD);
#pragma unroll
        for (int r = 0; r < 5; ++r) { const int q = tid + 512 * r; if (q < MLP * 16) sv[dir][r] = __builtin_nontemporal_load((const GAS v4u*)(st + (size_t)(q >> 4) * MLD + 8 * (q & 15))); } }
#pragma unroll
    for (int ks = 0; ks < 4; ++ks) qf[ks] = __builtin_nontemporal_load((const GAS v4u*)(P.QB + (size_t)(row0 + tl) * MLW + hh * MLD + 32 * ks + 8 * g));
    const float cpv0 = M0[(size_t)bh * NCH + c], cpv1 = M0[(size_t)(8 + bh) * NCH + c];
    ml_load_gates(P.GATES, P.SS, P.bg, row0, hh, G4, tid);
    __syncthreads();
    if (wave < 2) { const int dir = wave; const LAS float* li = G4 + 2 * dir * MLC; const LAS float* lf = li + MLC;
        const int t0 = dir ? MLC - 1 - 2 * lane : 2 * lane, t1 = dir ? t0 - 1 : t0 + 1;
        const float x0 = lf[t0], x1 = lf[t1]; const float S = wave_incl_sum(x0 + x1, lane); const float f0 = S - x1, f1 = S;
        const float a0 = li[t0] - f0, a1 = li[t1] - f1; const float cp = dir ? cpv1 : cpv0;
        AF[dir * MLC + t0] = __expf(a0 - cp); AF[dir * MLC + t1] = __expf(a1 - cp);
        CLA[dir * MLC + t0] = __expf(-(f0 + cp)); CLA[dir * MLC + t1] = __expf(-(f1 + cp)); }
    {
#pragma unroll
      for (int r = 0; r < 4; ++r) { const int q = tid + 512 * r, s = q >> 4, ce = q & 15; *(LAS v4u*)(KS + s * MLPB + 16 * ce) = kk_[r]; *(LAS v4u*)(VP + s * MLPB + 16 * ce) = vv_[r]; } }
    if (tid < MLC) { *(LAS v4u*)(VP + tid * MLPB + 256) = (v4u){0x00003F80u, 0u, 0u, 0u}; *(LAS v4u*)(VP + tid * MLPB + 272) = (v4u){0u, 0u, 0u, 0u}; }
    {
#pragma unroll
      for (int dir = 0; dir < 2; ++dir)
#pragma unroll
          for (int r = 0; r < 5; ++r) { const int q = tid + 512 * r; if (q < MLP * 16) *(LAS v4u*)(ST + dir * MLP * MLPB + (q >> 4) * MLPB + 16 * (q & 15)) = sv[dir][r]; } }
    __syncthreads();
    u32x2v ovp[8];
#pragma unroll
    for (int n = 0; n < 8; ++n) ovp[n] = __builtin_nontemporal_load((const GAS u32x2v*)(P.PROJ + (size_t)(row0 + tl) * NPROJ + PC_O + hh * MLD + 16 * n + 4 * g));
    f32x4 sT[8];
#pragma unroll
    for (int mt = 0; mt < 8; ++mt) { __builtin_amdgcn_sched_barrier(0); sT[mt] = (f32x4){0.f, 0.f, 0.f, 0.f};
#pragma unroll
        for (int ks = 0; ks < 4; ++ks) { const bf16x8 kf = *(const LAS bf16x8*)(KS + (16 * mt + i) * MLPB + 64 * ks + 16 * g);
            sT[mt] = __builtin_amdgcn_mfma_f32_16x16x32_bf16(kf, __builtin_bit_cast(bf16x8, qf[ks]), sT[mt], 0, 0, 0); } }
    f32x4 o[2][9];
#pragma unroll
    for (int d = 0; d < 2; ++d)
#pragma unroll
        for (int n = 0; n < 9; ++n) o[d][n] = (f32x4){0.f, 0.f, 0.f, 0.f};
    const int troff = (4 * g + tq) * MLPB + 8 * tp;
#pragma unroll
    for (int dir = 0; dir < 2; ++dir) {
#pragma unroll
        for (int kk = 0; kk < 4; ++kk) {
            __builtin_amdgcn_sched_barrier(0);
            const bool need = dir == 0 ? (2 * kk <= wave) : (2 * kk + 1 >= wave);
            if (need) {
                float p[8];
#pragma unroll
                for (int h2 = 0; h2 < 2; ++h2) { const int mt = 2 * kk + h2; const f32x4 av = *(const LAS f32x4*)(AF + dir * MLC + 16 * mt + 4 * g);
#pragma unroll
                    for (int r = 0; r < 4; ++r) { const int s = 16 * mt + 4 * g + r; const bool ok = dir == 0 ? (s <= tl) : (s >= tl);
                        p[4 * h2 + r] = ok ? sT[mt][r] * av[r] : 0.f; } }
                v4u pw; pw.x = cvtpk(p[0], p[1]); pw.y = cvtpk(p[2], p[3]); pw.z = cvtpk(p[4], p[5]); pw.w = cvtpk(p[6], p[7]);
                const bf16x8 pb = __builtin_bit_cast(bf16x8, pw);
                const int so = troff + 32 * kk * MLPB;
#pragma unroll
                for (int n = 0; n < 9; ++n) { const bf16x8 va = tr_pair(VP + so + 32 * n, VP + so + 16 * MLPB + 32 * n);
                    o[dir][n] = __builtin_amdgcn_mfma_f32_16x16x32_bf16(va, pb, o[dir][n], 0, 0, 0); }
            }
        }
    }
#pragma unroll
    for (int dir = 0; dir < 2; ++dir) {
#pragma unroll
        for (int ks = 0; ks < 4; ++ks) { __builtin_amdgcn_sched_barrier(0); const bf16x8 qs = __builtin_bit_cast(bf16x8, qf[ks]);
#pragma unroll
            for (int n = 0; n < 9; ++n) { const bf16x8 sa = *(const LAS bf16x8*)(ST + dir * MLP * MLPB + (16 * n + i) * MLPB + 64 * ks + 16 * g);
                o[dir][n] = __builtin_amdgcn_mfma_f32_16x16x32_bf16(sa, qs, o[dir][n], 0, 0, 0); } }
    }
    __builtin_amdgcn_sched_barrier(0);
    float inv[2];
#pragma unroll
    for (int dir = 0; dir < 2; ++dir) { const float den = __shfl(o[dir][8][0], i); inv[dir] = __builtin_amdgcn_rcpf(fmaxf(fabsf(den), CLA[dir * MLC + tl])); }
    float ssq = 0.f;
#pragma unroll
    for (int n = 0; n < 8; ++n)
#pragma unroll
        for (int r = 0; r < 4; ++r) { const float h = o[0][n][r] * inv[0] + o[1][n][r] * inv[1]; o[0][n][r] = h; ssq += h * h; }
    ssq += __shfl_xor(ssq, 16); ssq += __shfl_xor(ssq, 32);
    const float rs = __builtin_amdgcn_rsqf(ssq * (1.0f / MLD) + EPS);
    const size_t row = (size_t)(row0 + tl);
#pragma unroll
    for (int n2 = 0; n2 < 4; ++n2) { u32x2v wy[2]; const bool godd = (g & 1) != 0;
#pragma unroll
      for (int h2 = 0; h2 < 2; ++h2) { const int n = 2 * n2 + h2; const int d = 16 * n + 4 * g; const f32x4 gnv = gnw[n];
        const u32x2v ov = ovp[n];
        const float og0 = bflo(ov.x), og1 = bfhi(ov.x), og2 = bflo(ov.y), og3 = bfhi(ov.y);
#define SIGM(x_) __builtin_amdgcn_rcpf(1.0f + __builtin_amdgcn_exp2f((x_) * -1.4426950408889634f))
        const float y0 = o[0][n][0] * rs * gnv[0] * SIGM(og0), y1 = o[0][n][1] * rs * gnv[1] * SIGM(og1);
        const float y2 = o[0][n][2] * rs * gnv[2] * SIGM(og2), y3 = o[0][n][3] * rs * gnv[3] * SIGM(og3);
#undef SIGM
        wy[h2].x = cvtpk(y0, y1); wy[h2].y = cvtpk(y2, y3); }
      const unsigned rx = __shfl_xor(godd ? wy[0].x : wy[1].x, 16), ry = __shfl_xor(godd ? wy[0].y : wy[1].y, 16);
      v4u oy; if (godd) { oy.x = rx; oy.y = ry; oy.z = wy[1].x; oy.w = wy[1].y; } else { oy.x = wy[0].x; oy.y = wy[0].y; oy.z = rx; oy.w = ry; }
      *(GAS v4u*)(P.Y + row * D + hh * MLD + 16 * (2 * n2 + (godd ? 1 : 0)) + 4 * (g & ~1)) = oy; }
    __syncthreads();
}


constexpr int WG_PITCH = 2048 + 16;
__device__ __forceinline__ void gates_mfma(const Ptrs& P, const bf16* WGH, const bf16* WGL, LAS unsigned char* lds, int first, int end, int stride, int tid, int lane) {
    const int i = lane & 15, g = lane >> 4;
    __syncthreads();
#pragma unroll
    for (int r = 0; r < 8; ++r) { const int q = tid + 512 * r, hl = q >> 11, row = (q >> 7) & 15, ch = q & 127;
        *(LAS v4u*)(lds + hl * 16 * WG_PITCH + row * WG_PITCH + 16 * ch) = *(const GAS v4u*)((hl ? WGL : WGH) + (size_t)row * D + 8 * ch); }
    __syncthreads();
    for (int task = first; task < end; task += stride) {
        const int row0 = (task >> 1) * 16, kh = task & 1;
        f32x4 acc = (f32x4){0.f, 0.f, 0.f, 0.f};
        const bf16* xr = P.XB + (size_t)(row0 + i) * D + 512 * kh + 8 * g; const LAS unsigned char* wh = lds + i * WG_PITCH + (512 * kh + 8 * g) * 2; const LAS unsigned char* wl = wh + 16 * WG_PITCH;
        bf16x8 a[16];
#pragma unroll
        for (int ks = 0; ks < 16; ++ks) a[ks] = *(const GAS bf16x8*)(xr + 32 * ks);
#pragma unroll
        for (int ks = 0; ks < 16; ++ks) {
            const bf16x8 bh = *(const LAS bf16x8*)(wh + 64 * ks), bl = *(const LAS bf16x8*)(wl + 64 * ks);
            acc = __builtin_amdgcn_mfma_f32_16x16x32_bf16(a[ks], bh, acc, 0, 0, 0);
            acc = __builtin_amdgcn_mfma_f32_16x16x32_bf16(a[ks], bl, acc, 0, 0, 0);
        }
#pragma unroll
        for (int r = 0; r < 4; ++r) P.GATES[(size_t)kh * M * NG + (size_t)(row0 + 4 * g + r) * NG + i] = acc[r];
    }
    __syncthreads();
}

constexpr int NA_ROWS = 9, NA_KS = 0, NA_VS = NA_ROWS * 64 * 128, NA_BT = 2 * NA_VS;
__device__ __forceinline__ void na_phase(const Ptrs& P, LAS unsigned char* lds, int first, int end, int stride, int tid, int wave, int lane) {
    typedef unsigned u32x2v __attribute__((ext_vector_type(2)));
    if (first >= end) return;
    LAS float* BT = (LAS float*)(lds + NA_BT);
    const int i = lane & 15, g = lane >> 4, qt = wave & 3, c = 16 * qt + i;
    const int cs = min(max(c - 8, 0), GW - 16), ws = qt == 0 ? 0 : qt == 1 ? 8 : qt == 2 ? 24 : 32;
    const int skey = tid >> 3, sch = tid & 7;
    const int sdst = skey * 128 + ((sch ^ (skey & 7)) << 4);
    const f32x4 gq0 = *(const GAS f32x4*)(P.gq + 8 * g) * *(const GAS f32x4*)(P.gk + 8 * g), gq1 = *(const GAS f32x4*)(P.gq + 8 * g + 4) * *(const GAS f32x4*)(P.gk + 8 * g + 4),
        gq2 = *(const GAS f32x4*)(P.gq + 32 + 8 * g) * *(const GAS f32x4*)(P.gk + 32 + 8 * g), gq3 = *(const GAS f32x4*)(P.gq + 32 + 8 * g + 4) * *(const GAS f32x4*)(P.gk + 32 + 8 * g + 4);
    const int kq = 4 * g + (i >> 2), tp = i & 3;
    int voff[4];
#pragma unroll
    for (int md = 0; md < 4; ++md) voff[md] = (ws + kq) * 128 + (((2 * md + (tp >> 1)) ^ (kq & 7)) << 4) + 8 * (tp & 1);
    int koff[2];
#pragma unroll
    for (int ks = 0; ks < 2; ++ks) koff[ks] = (ws + i) * 128 + (((4 * ks + g) ^ (i & 7)) << 4);
    float okf[8]; int bto[8];
#pragma unroll
    for (int h = 0; h < 2; ++h)
#pragma unroll
        for (int r = 0; r < 4; ++r) { const int kc = ws + 16 * h + 4 * g + r; okf[4 * h + r] = (kc >= cs && kc < cs + 16) ? 1.f : 0.f; bto[4 * h + r] = (kc - c + 15) & 31; }
    v4u pk[NA_ROWS], pv[NA_ROWS], pq0, pq1;
#define NA_NEED(kr_, bhd_, pra_, pbhd_) ((kr_) < GROWS && !((bhd_) == (pbhd_) && (kr_) >= (pra_) && (kr_) <= (pra_) + 8))
#define NA_LOAD(unit_, pra_, pbhd_) do { const int j_ = (unit_) & 63, bhd_ = (unit_) >> 6, b_ = bhd_ >> 3, hd_ = bhd_ & 7, r0_ = 2 * j_, ra_ = min(max(r0_ - 4, 0), GROWS - 8); \
        _Pragma("unroll") for (int rr = 0; rr < NA_ROWS; ++rr) { const int kr = ra_ + rr; if (NA_NEED(kr, bhd_, pra_, pbhd_)) { const size_t ktok = (size_t)b_ * T + kr * GW + skey; \
            pk[rr] = *(const GAS v4u*)(P.PROJ + ktok * NPROJ + PC_KN + hd_ * NAD + 8 * sch); pv[rr] = *(const GAS v4u*)(P.PROJ + ktok * NPROJ + PC_VN + hd_ * NAD + 8 * sch); } } \
        const size_t qtok_ = (size_t)b_ * T + (r0_ + (wave >> 2)) * GW + c; \
        pq0 = *(const GAS v4u*)(P.PROJ + qtok_ * NPROJ + PC_QN + hd_ * NAD + 8 * g); pq1 = *(const GAS v4u*)(P.PROJ + qtok_ * NPROJ + PC_QN + hd_ * NAD + 32 + 8 * g); } while (0)
    int pra = -100, pbhd = -1;
#pragma unroll
    for (int rr = 0; rr < NA_ROWS; ++rr) { pk[rr] = (v4u){0u, 0u, 0u, 0u}; pv[rr] = (v4u){0u, 0u, 0u, 0u}; }
    NA_LOAD(first, pra, pbhd);
#pragma unroll 1
    for (int unit = first; unit < end; unit += stride) {
        const int j = unit & 63, bhd = unit >> 6, b = bhd >> 3, hd = bhd & 7, r0 = 2 * j, ra = min(max(r0 - 4, 0), GROWS - 8);
        const int qrow = r0 + (wave >> 2), rsw = min(max(qrow - 4, 0), GROWS - 8);
        const size_t qtok = (size_t)b * T + qrow * GW + c;
        __syncthreads();
        if (bhd != pbhd && tid < 480) { const int dr = tid >> 5, dc = tid & 31; BT[tid] = dc < 31 ? P.rpb[(hd * 15 + dr) * 31 + dc] * 1.4426950408889634f : 0.f; }
#pragma unroll
        for (int rr = 0; rr < NA_ROWS; ++rr) { const int krs = ra + rr; if (!NA_NEED(krs, bhd, pra, pbhd)) continue; const int sl = krs % 9; const v4u kv = pk[rr];
            float x[8]; x[0] = bflo(kv.x); x[1] = bfhi(kv.x); x[2] = bflo(kv.y); x[3] = bfhi(kv.y); x[4] = bflo(kv.z); x[5] = bfhi(kv.z); x[6] = bflo(kv.w); x[7] = bfhi(kv.w);
            float ss = (x[0] * x[0] + x[1] * x[1]) + (x[2] * x[2] + x[3] * x[3]) + (x[4] * x[4] + x[5] * x[5]) + (x[6] * x[6] + x[7] * x[7]);
            ss += __shfl_xor(ss, 1); ss += __shfl_xor(ss, 2); ss += __shfl_xor(ss, 4);
            const float rk = __builtin_amdgcn_rsqf(ss * (1.0f / NAD) + EPS);
            v4u kn; kn.x = cvtpk(x[0] * rk, x[1] * rk); kn.y = cvtpk(x[2] * rk, x[3] * rk); kn.z = cvtpk(x[4] * rk, x[5] * rk); kn.w = cvtpk(x[6] * rk, x[7] * rk);
            *(LAS v4u*)(lds + NA_KS + sl * 8192 + sdst) = kn; *(LAS v4u*)(lds + NA_VS + sl * 8192 + sdst) = pv[rr]; }
        pra = ra; pbhd = bhd;
        bf16x8 qf[2];
        { float x[16]; x[0] = bflo(pq0.x); x[1] = bfhi(pq0.x); x[2] = bflo(pq0.y); x[3] = bfhi(pq0.y); x[4] = bflo(pq0.z); x[5] = bfhi(pq0.z); x[6] = bflo(pq0.w); x[7] = bfhi(pq0.w);
          x[8] = bflo(pq1.x); x[9] = bfhi(pq1.x); x[10] = bflo(pq1.y); x[11] = bfhi(pq1.y); x[12] = bflo(pq1.z); x[13] = bfhi(pq1.z); x[14] = bflo(pq1.w); x[15] = bfhi(pq1.w);
          float ss = 0.f;
#pragma unroll
          for (int k = 0; k < 16; ++k) ss += x[k] * x[k];
          ss += __shfl_xor(ss, 16); ss += __shfl_xor(ss, 32);
          const float rq = (0.125f * 1.4426950408889634f) * __builtin_amdgcn_rsqf(ss * (1.0f / NAD) + EPS);
          v4u a, bq; a.x = cvtpk(x[0] * rq * gq0[0], x[1] * rq * gq0[1]); a.y = cvtpk(x[2] * rq * gq0[2], x[3] * rq * gq0[3]); a.z = cvtpk(x[4] * rq * gq1[0], x[5] * rq * gq1[1]); a.w = cvtpk(x[6] * rq * gq1[2], x[7] * rq * gq1[3]);
          bq.x = cvtpk(x[8] * rq * gq2[0], x[9] * rq * gq2[1]); bq.y = cvtpk(x[10] * rq * gq2[2], x[11] * rq * gq2[3]); bq.z = cvtpk(x[12] * rq * gq3[0], x[13] * rq * gq3[1]); bq.w = cvtpk(x[14] * rq * gq3[2], x[15] * rq * gq3[3]);
          qf[0] = __builtin_bit_cast(bf16x8, a); qf[1] = __builtin_bit_cast(bf16x8, bq); }
        __syncthreads();
        if (unit + stride < end) NA_LOAD(unit + stride, pra, pbhd);
        f32x4 o[4];
#pragma unroll
        for (int md = 0; md < 4; ++md) o[md] = (f32x4){0.f, 0.f, 0.f, 0.f};
        float den = 0.f;
#pragma unroll 1
        for (int rr = rsw - ra; rr < rsw - ra + 8; ++rr) {
            const int kr = ra + rr, sl = kr % 9;
            f32x4 s[2];
#pragma unroll
            for (int h = 0; h < 2; ++h) { s[h] = (f32x4){0.f, 0.f, 0.f, 0.f};
#pragma unroll
                for (int ks = 0; ks < 2; ++ks) { const bf16x8 kf = *(const LAS bf16x8*)(lds + NA_KS + sl * 8192 + h * 2048 + koff[ks]); s[h] = __builtin_amdgcn_mfma_f32_16x16x32_bf16(kf, qf[ks], s[h], 0, 0, 0); } }
            const LAS float* btr = BT + (kr - qrow + 7) * 32; float p[8];
#pragma unroll
            for (int h = 0; h < 2; ++h)
#pragma unroll
                for (int r = 0; r < 4; ++r) { p[4 * h + r] = __builtin_amdgcn_exp2f(s[h][r] + btr[bto[4 * h + r]]) * okf[4 * h + r]; den += p[4 * h + r]; }
            v4u pw; pw.x = cvtpk(p[0], p[1]); pw.y = cvtpk(p[2], p[3]); pw.z = cvtpk(p[4], p[5]); pw.w = cvtpk(p[6], p[7]);
            const bf16x8 pb = __builtin_bit_cast(bf16x8, pw);
#pragma unroll
            for (int md = 0; md < 4; ++md) { const bf16x8 va = tr_pair(lds + NA_VS + sl * 8192 + voff[md], lds + NA_VS + sl * 8192 + 2048 + voff[md]);
                o[md] = __builtin_amdgcn_mfma_f32_16x16x32_bf16(va, pb, o[md], 0, 0, 0); }
        }
        den += __shfl_xor(den, 16); den += __shfl_xor(den, 32);
        const float inv = __builtin_amdgcn_rcpf(den);
#pragma unroll
        for (int m2 = 0; m2 < 2; ++m2) { const bool godd = (g & 1) != 0;
            const unsigned a0 = cvtpk(o[2 * m2][0] * inv, o[2 * m2][1] * inv), a1 = cvtpk(o[2 * m2][2] * inv, o[2 * m2][3] * inv), b0 = cvtpk(o[2 * m2 + 1][0] * inv, o[2 * m2 + 1][1] * inv), b1 = cvtpk(o[2 * m2 + 1][2] * inv, o[2 * m2 + 1][3] * inv);
            const unsigned rx = __shfl_xor(godd ? a0 : b0, 16), ry = __shfl_xor(godd ? a1 : b1, 16);
            v4u oy; if (godd) { oy.x = rx; oy.y = ry; oy.z = b0; oy.w = b1; } else { oy.x = a0; oy.y = a1; oy.z = rx; oy.w = ry; }
            *(GAS v4u*)(P.Y + qtok * D + MLW + hd * NAD + 16 * (2 * m2 + (godd ? 1 : 0)) + 4 * (g & ~1)) = oy; }
    }
#undef NA_LOAD
#undef NA_NEED
    __syncthreads();
}

__device__ __forceinline__ void final_norm(const Ptrs& P, int gw, int NGW, int lane) {
    const GAS f32x4* gr = (const GAS f32x4*)P.gf + lane; f32x4 gv[4];
#pragma unroll
    for (int j = 0; j < 4; ++j) gv[j] = gr[64 * j];
    for (int m0 = gw; m0 < M; m0 += 4 * NGW) {
        f32x4 v[4][4]; float rs[4];
#pragma unroll
        for (int r = 0; r < 4; ++r) { const int mm = (m0 + r * NGW) < M ? (m0 + r * NGW) : m0; GAS f32x4* xr = (GAS f32x4*)(P.out + (size_t)mm * D) + lane;
#pragma unroll
            for (int j = 0; j < 4; ++j) v[r][j] = xr[64 * j];
            rs[r] = pg8::rstd_from_ss(P.SS, mm); }
#pragma unroll
        for (int r = 0; r < 4; ++r) { const int mm = m0 + r * NGW; if (mm < M) { GAS f32x4* xr = (GAS f32x4*)(P.out + (size_t)mm * D) + lane;
#pragma unroll
            for (int j = 0; j < 4; ++j) xr[64 * j] = v[r][j] * rs[r] * gv[j]; } }
    }
}

#define MAKE_P() Ptrs P; do { \
    P.x = args.in[0]; P.g1 = args.in[1]; P.w1g = args.in[2]; P.w1u = args.in[3]; P.w1d = args.in[4]; P.gm = args.in[5]; P.win = args.in[6]; P.bg = args.in[7]; P.cw = args.in[8]; P.cb = args.in[9]; \
    P.wq = args.in[10]; P.wk = args.in[11]; P.gn = args.in[12]; P.gq = args.in[13]; P.gk = args.in[14]; P.rpb = args.in[15]; P.wout = args.in[16]; P.g2 = args.in[17]; P.w2g = args.in[18]; P.w2u = args.in[19]; \
    P.w2d = args.in[20]; P.gf = args.in[21]; P.out = args.out; \
    P.W1T = (bf16*)(ws + WS_W1T); P.W1DT = (bf16*)(ws + WS_W1DT); P.WINT = (bf16*)(ws + WS_WINT); P.WOUTT = (bf16*)(ws + WS_WOUTT); P.W2T = (bf16*)(ws + WS_W2T); P.W2DT = (bf16*)(ws + WS_W2DT); \
    P.XB = (bf16*)(ws + WS_XB); P.QB = (bf16*)args.out; P.KB = (bf16*)((unsigned char*)args.out + 16 * MiB); P.H = (bf16*)(ws + WS_HP); P.PROJ = (bf16*)(ws + WS_HP); P.Y = (bf16*)(ws + WS_Y); \
    P.WQT = (bf16*)(ws + WS_WQT); P.WKT = (bf16*)(ws + WS_WQT + 131072); P.WGH = (bf16*)(ws + WS_WG); P.WGL = (bf16*)(ws + WS_WG + 32768); P.SS = (float*)(ws + WS_SS); P.GATES = (float*)(ws + WS_GATES); } while (0)
#ifndef MK_N_LAUNCHES
#define MK_N_LAUNCHES 1
#endif
constexpr int NA_UNITS_P4 = 768;
constexpr int NPH = 10;
constexpr int N_LAUNCHES = MK_N_LAUNCHES;
struct Args { const float* in[22]; float* out; unsigned char* ws; int ph_lo, ph_hi; };
__global__ void __launch_bounds__(NWAVES * 64, 2) fwd_megakernel(Args args) {
    extern __shared__ __attribute__((aligned(16))) unsigned char lds_raw[];
    LAS unsigned char* lds = (LAS unsigned char*)lds_raw;
    volatile LAS unsigned* MISC = (volatile LAS unsigned*)(lds + MISC_OFF);
    const int tid = threadIdx.x, lane = tid & 63, wave = __builtin_amdgcn_readfirstlane(tid >> 6);
    const int G = gridDim.x, bx = blockIdx.x, vcu = (G % 8 == 0) ? (bx % 8) * (G / 8) + bx / 8 : bx;
    const int gw = vcu * NWAVES + wave, NGW = G * NWAVES, gtid = vcu * NWAVES * 64 + tid, NGT = G * NWAVES * 64;
    unsigned char* ws = args.ws;
    gu32* ctl = (gu32*)(ws + WS_CTL);
    for (int u = tid; u < (LDS_BYTES - LDSCTL_OFF) / 4; u += NWAVES * 64) ((LAS unsigned*)(lds + LDSCTL_OFF))[u] = 0u;
    __syncthreads();
    XcdBarrier bar; bar.bar = (unsigned*)(ctl + CW_BAR); bar.x = 0; bar.st = nullptr;
    if (N_LAUNCHES == 1) bar = xcd_barrier_post((unsigned*)(ctl + CW_BAR), MISC + 8);
#define GRID_BAR() do { if (N_LAUNCHES == 1) xcd_barrier(bar); } while (0)
    const bool tied = (G == 256);
    const int pm_own = 8 * (bx % 8) + (bx / 8) % 8;
    LAS float* const RT = (LAS float*)(lds + RING_BYTES);
#define FILL_RT() do { if (tied) { __syncthreads(); if (tid < 256) RT[tid] = pg8::rstd_from_ss(P.SS, 256 * pm_own + tid); __syncthreads(); } } while (0)
    const int lo = args.ph_lo, hi = args.ph_hi;
#ifndef PHASE_MASK
#define PHASE_MASK 0xFFFF
#endif
#define IN(k) (((PHASE_MASK >> (k)) & 1) && lo <= (k) && (k) < hi)
#define BOTH(k) (IN(k) && IN((k) + 1))
#ifndef PHASE_DUP
#define PHASE_DUP 0
#endif
#define REP(k) for (int rep_ = 0; rep_ < (((PHASE_DUP >> (k)) & 1) ? 2 : 1); ++rep_)

    if (IN(0)) { MAKE_P(); REP(0) p0_prologue(P, lds, gw, NGW, lane, wave, gtid, NGT); if (BOTH(0)) GRID_BAR(); }
    if (IN(1)) { MAKE_P(); REP(1) { pg8::Gemm g{P.XB, P.W1T, M, NFF2, D}; pg8::StaticOrder S; S.init(M, NFF2, G, bx); FILL_RT(); pg8::EpiSwiGLU E{P.H, FF, P.SS, tied ? (const LAS float*)RT : (const LAS float*)nullptr};
        pg8::gemm_phase<pg8::EpiSwiGLU, pg8::StaticOrder, true, true>(lds + RING_OFF, g, S, E); }
        if (bx >= G / 2) p0_deferred(P, lds, 0, 5248, (bx - G / 2) * NWAVES + wave, (G / 2) * NWAVES, lane, wave);
        if (BOTH(1)) GRID_BAR(); }
    if (IN(2)) { MAKE_P(); REP(2) { pg8::Gemm g{P.H, P.W1DT, M, D, FF}; pg8::StaticOrder S; S.init(M, D, G, bx); pg8::EpiResidG E{P.XB, P.SS, 0.5f, D, P.WGH, P.WGL, P.GATES, M};
        pg8::gemm_phase<pg8::EpiResidG, pg8::StaticOrder, true, true>(lds + RING_OFF, g, S, E); } if (BOTH(2)) GRID_BAR(); }
    if (IN(3)) { MAKE_P(); REP(3) {
        pg8::Gemm g{P.XB, P.WINT, M, NPROJ, D}; pg8::StaticOrder S; S.init(M, NPROJ, G, bx); FILL_RT(); pg8::EpiProj E{P.PROJ, NPROJ, P.SS, tied ? (const LAS float*)RT : (const LAS float*)nullptr};
        pg8::gemm_phase<pg8::EpiProj, pg8::StaticOrder, true, true>(lds + RING_OFF, g, S, E); } if (BOTH(3)) GRID_BAR(); }
    if (IN(4)) { MAKE_P(); REP(4) { { const int hh = (vcu / NCH) & 3, i = lane & 15, g = lane >> 4;
          bf16x8 aq[4], ak[4];
#pragma unroll
    for (int ks = 0; ks < 4; ++ks) { aq[ks] = *(const GAS bf16x8*)(P.WQT + (size_t)(hh * MLD + 16 * wave + i) * MLD + 32 * ks + 8 * g); ak[ks] = *(const GAS bf16x8*)(P.WKT + (size_t)(hh * MLD + 16 * wave + i) * MLD + 32 * ks + 8 * g); }
          for (int unit = vcu; unit < 8 * NCH; unit += G) mlb_unit(P, (bf16*)(ws + WS_CL), (float*)(ws + WS_CHS), lds, unit, tid, wave, lane, aq, ak); }
        na_phase(P, lds, 3 * vcu, 3 * vcu + 3, 1, tid, wave, lane); } if (BOTH(4)) GRID_BAR(); }
    if (IN(5)) { MAKE_P();
        if (!(vcu & 1)) ml_scan((bf16*)(ws + WS_CL), (const float*)(ws + WS_CHS), (float*)(ws + WS_M0), lds, vcu >> 1, tid);
        else { na_phase(P, lds, NA_UNITS_P4 + 2 * (vcu >> 1), NA_UNITS_P4 + 2 * (vcu >> 1) + 2, 1, tid, wave, lane);
            p0_deferred(P, lds, 5248, 6272, (vcu >> 1) * NWAVES + wave, 128 * NWAVES, lane, wave); }         if (BOTH(5)) GRID_BAR(); }
    if (IN(6)) { MAKE_P(); REP(6) { { f32x4 gnw[8]; const int hh = (vcu / NCH) & 3, g = lane >> 4;
#pragma unroll
          for (int n = 0; n < 8; ++n) gnw[n] = *(const GAS f32x4*)(P.gn + hh * MLD + 16 * n + 4 * g);
          for (int unit = vcu; unit < 8 * NCH; unit += G) mld_unit(P, (const bf16*)(ws + WS_CL), (const float*)(ws + WS_M0), lds, unit, tid, wave, lane, gnw); } } if (BOTH(6)) GRID_BAR(); }
    if (IN(7)) { MAKE_P(); pg8::Gemm g{P.Y, P.WOUTT, M, D, D}; pg8::StaticOrder S; S.init(M, D, G, bx); pg8::EpiResid<true, false, true> E{P.XB, nullptr, P.XB, P.SS, 1.0f, D, nullptr, nullptr, nullptr};
        pg8::gemm_phase<pg8::EpiResid<true, false, true>, pg8::StaticOrder, true, true>(lds + RING_OFF, g, S, E); if (BOTH(7)) GRID_BAR(); }
    if (IN(8)) { MAKE_P(); REP(8) { pg8::Gemm g{P.XB, P.W2T, M, NFF2, D}; pg8::StaticOrder S; S.init(M, NFF2, G, bx); FILL_RT(); pg8::EpiSwiGLU E{P.H, FF, P.SS, tied ? (const LAS float*)RT : (const LAS float*)nullptr};
        pg8::gemm_phase<pg8::EpiSwiGLU, pg8::StaticOrder, true, true>(lds + RING_OFF, g, S, E); }
        if (bx >= G / 2) p0_deferred(P, lds, 6272, 7680, (bx - G / 2) * NWAVES + wave, (G / 2) * NWAVES, lane, wave);
        if (BOTH(8)) GRID_BAR(); }
    if (IN(9)) { MAKE_P(); pg8::Gemm g{P.H, P.W2DT, M, D, FF}; pg8::StaticOrder S; S.init(M, D, G, bx); pg8::EpiResid<true, true, false, true, 1> E{P.XB, P.out, nullptr, P.SS, 0.5f, D, (float*)(ws + WS_XS), (unsigned*)(ctl + CW_PAN), P.gf};
        pg8::gemm_phase<pg8::EpiResid<true, true, false, true, 1>, pg8::StaticOrder, true, true>(lds + RING_OFF, g, S, E); }
#undef IN
#undef BOTH
#undef GRID_BAR
#undef FILL_RT
}

extern "C" void kernel_launch(void* const* d_in, const int* in_sizes, int n_in, void* d_out, int out_size, void* d_ws, size_t ws_size, hipStream_t stream) {
    static int grid = 0;
    if (grid == 0) {
        if (n_in != 22 || in_sizes[0] != M * D || out_size != M * D || ws_size < WS_END) { fprintf(stderr, "kernel_launch: unexpected shapes (n_in %d, in0 %d, out %d, ws %zu)\n", n_in, n_in > 0 ? in_sizes[0] : -1, out_size, ws_size); grid = -1; return; }
        int dev = 0, cus = 0, per_cu = 0;
        if (hipGetDevice(&dev) != hipSuccess || hipDeviceGetAttribute(&cus, hipDeviceAttributeMultiprocessorCount, dev) != hipSuccess) { grid = -1; return; }
        if (hipFuncSetAttribute((const void*)fwd_megakernel, hipFuncAttributeMaxDynamicSharedMemorySize, LDS_BYTES) != hipSuccess) { fprintf(stderr, "kernel_launch: hipFuncSetAttribute failed\n"); grid = -1; return; }
        if (hipOccupancyMaxActiveBlocksPerMultiprocessor(&per_cu, (const void*)fwd_megakernel, NWAVES * 64, LDS_BYTES) != hipSuccess || per_cu < 1) { fprintf(stderr, "kernel_launch: occupancy query says %d blocks per CU\n", per_cu); per_cu = 1; }
        (void)hipGetLastError();
        if (cus < 256) { fprintf(stderr, "kernel_launch: this kernel is built for the 256-CU MI355X (one workgroup per CU, 256 workgroups); the device reports %d CUs; nothing launched\n", cus); grid = -1; return; }
        grid = 256;
    }
    if (grid < 0) return;
    (void)hipMemsetAsync((char*)d_ws + WS_CTL, 0, 65536, stream);
    Args a{};
    for (int i = 0; i < 22; ++i) a.in[i] = (const float*)d_in[i];
    a.out = (float*)d_out; a.ws = (unsigned char*)d_ws;
    if (N_LAUNCHES == 1) { a.ph_lo = 0; a.ph_hi = NPH; hipLaunchKernelGGL(fwd_megakernel, dim3(grid), dim3(NWAVES * 64), LDS_BYTES, stream, a); }
    else for (int li = 0; li < NPH; ++li) { a.ph_lo = li; a.ph_hi = li + 1; hipLaunchKernelGGL(fwd_megakernel, dim3(grid), dim3(NWAVES * 64), LDS_BYTES, stream, a); }
}
```
